# Optimizing an MI355X kernel written in HIP

```python
import jax, jax.numpy as jnp
from jax import lax
import numpy as np

D_MODEL = 1024
BATCH = 2
SEQ = 8192
DEPTH = 2

MEM_LEN = 256
HEAD_DIM = 64
DIL_HEADS = 6
DIL_PATTERNS = ((128, 1), (512, 4), (2048, 16))
DIL_BLOCK = 128
SGU_GROUPS = 4
SGU_GROUP_DIM = 64
SGU_CHUNK = 128
RET_HEADS = 6
RET_CHUNK = 128
ROPE_BASE = 10000.0
A_WIDTH = DIL_HEADS * HEAD_DIM
B_WIDTH = SGU_GROUPS * SGU_GROUP_DIM
C_WIDTH = RET_HEADS * HEAD_DIM
MIX_WIDTH = A_WIDTH + B_WIDTH + C_WIDTH
IN_SPLITS = (A_WIDTH, A_WIDTH, A_WIDTH, B_WIDTH, B_WIDTH, C_WIDTH, C_WIDTH, C_WIDTH, C_WIDTH)
IN_WIDTH = sum(IN_SPLITS)
X_HEADS = 4
X_HEAD_DIM = D_MODEL // X_HEADS
D_FF = 4 * D_MODEL
N_NORMS = 7
EPS = 1e-6
F32 = jnp.float32

kernel_name = "hybrid_dilated_sgu_retention_block"


def rms_norm(x, g):
    xf = x.astype(F32)
    y = xf * lax.rsqrt(jnp.mean(xf * xf, axis=-1, keepdims=True) + EPS)
    return (y * g.astype(F32)).astype(x.dtype)


def dilated_branch(q, k, v, window, dilation):
    B, S, H, E = q.shape
    L = S // dilation
    span = window // dilation
    assert span <= DIL_BLOCK
    nb = -(-L // DIL_BLOCK)
    Lp = nb * DIL_BLOCK

    def to_sub(t):
        t = t.reshape(B, L, dilation, H, E).transpose(0, 2, 1, 3, 4)
        t = jnp.pad(t, ((0, 0), (0, 0), (0, Lp - L), (0, 0), (0, 0)))
        return t.reshape(B, dilation, nb, DIL_BLOCK, H, E).astype(F32)

    def band(t):
        prev = jnp.pad(t, ((0, 0), (0, 0), (1, 0), (0, 0), (0, 0), (0, 0)))[:, :, :nb]
        return jnp.concatenate([prev, t], axis=3)

    qb = to_sub(q)
    kk = band(to_sub(k))
    vv = band(to_sub(v))
    s = jnp.einsum('brnqhe,brnkhe->brnhqk', qb, kk) * (E ** -0.5)
    qi = jnp.arange(DIL_BLOCK)[:, None] + DIL_BLOCK
    ki = jnp.arange(2 * DIL_BLOCK)[None, :]
    dist = qi - ki
    blk = jnp.arange(nb)[:, None, None]
    valid = (dist >= 0) & (dist <= span) & ((blk * DIL_BLOCK - DIL_BLOCK + ki) >= 0)
    s = jnp.where(valid[:, None], s, -jnp.inf)
    m = jnp.max(s, axis=-1, keepdims=True)
    p = jnp.exp(s - m)
    den = jnp.sum(p, axis=-1)
    den_t = den.transpose(0, 1, 2, 4, 3)
    o = jnp.einsum('brnhqk,brnkhe->brnqhe', p, vv) / den_t[..., None]
    lse = (m[..., 0] + jnp.log(den)).transpose(0, 1, 2, 4, 3)

    def from_sub(t):
        rest = t.shape[4:]
        t = t.reshape((B, dilation, Lp) + rest)[:, :, :L]
        return jnp.swapaxes(t, 1, 2).reshape((B, S) + rest)

    return from_sub(o), from_sub(lse)


def dilated_attention(q, k, v):
    outs, lses = [], []
    for window, dilation in DIL_PATTERNS:
        o, l = dilated_branch(q, k, v, window, dilation)
        outs.append(o)
        lses.append(l)
    w = jax.nn.softmax(jnp.stack(lses, 0), axis=0)
    out = jnp.sum(w[..., None] * jnp.stack(outs, 0), axis=0)
    B, S = out.shape[:2]
    return out.reshape(B, S, A_WIDTH)


def spatial_gating(u, v, w_s, b_s, ln_g, ln_b):
    B, S, _ = u.shape
    u = jax.nn.gelu(u.astype(F32))
    v = jax.nn.gelu(v.astype(F32))
    mu = jnp.mean(v, axis=-1, keepdims=True)
    var = jnp.mean(jnp.square(v - mu), axis=-1, keepdims=True)
    v = (v - mu) * lax.rsqrt(var + EPS) * ln_g.astype(F32) + ln_b.astype(F32)
    v = v.reshape(B, S // SGU_CHUNK, SGU_CHUNK, SGU_GROUPS, SGU_GROUP_DIM)
    w = w_s.astype(F32) * jnp.tril(jnp.ones((SGU_CHUNK, SGU_CHUNK), F32))
    s = jnp.einsum('gij,bnjgc->bnigc', w, v) + b_s.astype(F32).T[None, None, :, :, None]
    return u * s.reshape(B, S, B_WIDTH)


def retention(q, k, v, g, positions):
    B, S, H, E = q.shape
    half = E // 2
    inv = 1.0 / (ROPE_BASE ** jnp.linspace(0.0, 1.0, half, dtype=F32))
    ang = positions.astype(F32)[..., None] * inv
    cos = jnp.cos(ang)[:, :, None, :]
    sin = jnp.sin(ang)[:, :, None, :]

    def rot(t):
        t = t.astype(F32)
        t1, t2 = t[..., :half], t[..., half:]
        return jnp.concatenate([t1 * cos - t2 * sin, t2 * cos + t1 * sin], axis=-1)

    q = rot(q)
    k = rot(k) * (E ** -0.5)
    v = v.astype(F32)
    log_g = jnp.log1p(-jnp.power(2.0, -5.0 - jnp.arange(H, dtype=F32)))
    C = RET_CHUNK
    nc = S // C
    qc = q.reshape(B, nc, C, H, E)
    kc = k.reshape(B, nc, C, H, E)
    vc = v.reshape(B, nc, C, H, E)
    idx = jnp.arange(C, dtype=F32)
    rel = idx[:, None] - idx[None, :]
    decay = jnp.where(rel[None] >= 0,
                      jnp.exp(jnp.maximum(rel, 0.0)[None] * log_g[:, None, None]), 0.0)
    inner = jnp.einsum('bnihe,bnjhe->bnhij', qc, kc) * decay
    y_in = jnp.einsum('bnhij,bnjhe->bnihe', inner, vc)
    k_dec = jnp.exp((C - 1 - idx)[:, None] * log_g[None, :])
    kv = jnp.einsum('bnjhk,bnjhv->nbhkv', kc * k_dec[:, :, None], vc)
    chunk_decay = jnp.exp(C * log_g)[None, :, None, None]

    def step(state, kv_n):
        return chunk_decay * state + kv_n, state

    _, prev = lax.scan(step, jnp.zeros((B, H, E, E), F32), kv)
    prev = prev.transpose(1, 0, 2, 3, 4)
    q_dec = jnp.exp((idx + 1.0)[:, None] * log_g[None, :])
    y_x = jnp.einsum('bnihk,bnhkv->bnihv', qc * q_dec[:, :, None], prev)
    y = (y_in + y_x).reshape(B, S, H, E)
    mu = jnp.mean(y, axis=-1, keepdims=True)
    var = jnp.mean(jnp.square(y - mu), axis=-1, keepdims=True)
    y = (y - mu) * lax.rsqrt(var + EPS)
    return jax.nn.silu(g.astype(F32)) * y.reshape(B, S, H * E)


def memory_attention(h, m, wq, wkv, wo):
    B, S, _ = h.shape
    M = m.shape[1]
    q = (h @ wq).reshape(B, S, X_HEADS, X_HEAD_DIM).astype(F32)
    kv = (m @ wkv).reshape(B, M, 2, X_HEADS, X_HEAD_DIM).astype(F32)
    s = jnp.einsum('bshe,bmhe->bhsm', q, kv[:, :, 0]) * (X_HEAD_DIM ** -0.5)
    p = jax.nn.softmax(s, axis=-1)
    o = jnp.einsum('bhsm,bmhe->bshe', p, kv[:, :, 1]).reshape(B, S, D_MODEL)
    return o.astype(h.dtype) @ wo


def setup_inputs(seed: int = 0) -> dict:
    key = jax.random.key(seed)
    ks = jax.random.split(key, 16)
    nrm = jax.random.normal
    x = nrm(ks[0], (BATCH, SEQ, D_MODEL), F32)
    mem = nrm(ks[1], (BATCH, MEM_LEN, D_MODEL), F32)
    offset = jax.random.randint(ks[2], (BATCH, 1), 0, 4096, dtype=jnp.int32)
    positions = offset + jnp.arange(SEQ, dtype=jnp.int32)[None, :]
    norm_g = 1.0 + 0.02 * nrm(ks[3], (DEPTH, N_NORMS, D_MODEL), F32)
    w_in = nrm(ks[4], (DEPTH, D_MODEL, IN_WIDTH), F32) * D_MODEL ** -0.5
    sgu_w = nrm(ks[5], (DEPTH, SGU_GROUPS, SGU_CHUNK, SGU_CHUNK), F32) * SGU_CHUNK ** -0.5
    sgu_b = 1.0 + 0.01 * nrm(ks[6], (DEPTH, SGU_GROUPS, SGU_CHUNK), F32)
    sgu_ln_g = 1.0 + 0.02 * nrm(ks[7], (DEPTH, B_WIDTH), F32)
    sgu_ln_b = 0.01 * nrm(ks[8], (DEPTH, B_WIDTH), F32)
    w_out = nrm(ks[9], (DEPTH, MIX_WIDTH, D_MODEL), F32) * MIX_WIDTH ** -0.5
    x_wq = nrm(ks[10], (DEPTH, D_MODEL, D_MODEL), F32) * D_MODEL ** -0.5
    x_wkv = nrm(ks[11], (DEPTH, D_MODEL, 2 * D_MODEL), F32) * D_MODEL ** -0.5
    x_wo = nrm(ks[12], (DEPTH, D_MODEL, D_MODEL), F32) * D_MODEL ** -0.5
    w_up = nrm(ks[13], (DEPTH, D_MODEL, D_FF), F32) * D_MODEL ** -0.5
    w_down = nrm(ks[14], (DEPTH, D_FF, D_MODEL), F32) * D_FF ** -0.5
    return {"x": x, "mem": mem, "positions": positions, "norm_g": norm_g,
            "w_in": w_in, "sgu_w": sgu_w, "sgu_b": sgu_b, "sgu_ln_g": sgu_ln_g,
            "sgu_ln_b": sgu_ln_b, "w_out": w_out, "x_wq": x_wq, "x_wkv": x_wkv,
            "x_wo": x_wo, "w_up": w_up, "w_down": w_down}


def reference(x, mem, positions, norm_g, w_in, sgu_w, sgu_b, sgu_ln_g, sgu_ln_b,
              w_out, x_wq, x_wkv, x_wo, w_up, w_down):
    B, S, _ = x.shape
    cuts = [int(c) for c in np.cumsum(IN_SPLITS)[:-1]]
    for l in range(DEPTH):
        g = norm_g[l]
        h = rms_norm(x, g[0])
        z = h @ w_in[l]
        qa, ka, va, ub, vb, qc, kc, vc, gc = jnp.split(z, cuts, axis=-1)
        head = lambda t, n: t.reshape(B, S, n, HEAD_DIM)
        ya = dilated_attention(head(qa, DIL_HEADS), head(ka, DIL_HEADS), head(va, DIL_HEADS))
        yb = spatial_gating(ub, vb, sgu_w[l], sgu_b[l], sgu_ln_g[l], sgu_ln_b[l])
        yc = retention(head(qc, RET_HEADS), head(kc, RET_HEADS), head(vc, RET_HEADS), gc, positions)
        mix = jnp.concatenate([ya, yb, yc], axis=-1).astype(x.dtype)
        x = x + rms_norm(mix @ w_out[l], g[1])
        mem_n = rms_norm(mem, g[6])
        x = x + rms_norm(memory_attention(rms_norm(x, g[2]), mem_n, x_wq[l], x_wkv[l], x_wo[l]), g[3])
        h = rms_norm(x, g[4])
        f = jnp.square(jax.nn.relu(h @ w_up[l])) @ w_down[l]
        x = x + rms_norm(f, g[5])
    return x
```

```cpp
#include <hip/hip_runtime.h>
#include <cstdio>
#include <cstdint>
#include <cmath>
namespace pg8 {
#define PG8_LAS __attribute__((address_space(3)))
typedef unsigned short bf16_t;
typedef short bf16x8 __attribute__((ext_vector_type(8)));
typedef float f32x4 __attribute__((ext_vector_type(4)));
typedef unsigned u32x4 __attribute__((ext_vector_type(4)));
constexpr int BM = 256, BK = 64, HALF = 128, HTB = HALF * BK * 2  , STAGE_BYTES = 8 * HTB, NXCD = 8, WGM = 8;

__host__ __device__ __forceinline__ int lds_byte(int r, int c) { const int st = (r >> 4) * 2 + (c >> 5), rr = r & 15, cc = c & 31, ob = rr * 64 + cc * 2; return st * 1024 + (ob ^ (((ob >> 9) & 1) << 5)); }
__host__ __device__ __forceinline__ void stage_rc(int b, int& R, int& C) { const int st = b / 1024, sb = b % 1024, swz = sb ^ (((sb >> 9) & 1) << 5); R = (st >> 1) * 16 + swz / 64; C = (st & 1) * 32 + (swz % 64) / 2; }
__host__ __device__ __forceinline__ int perm32(int rho) { const int n = rho >> 4, i = rho & 15; return 8 * (i >> 2) + 4 * n + (i & 3); }

struct Unit { int pm, pn; };
struct Gemm { const bf16_t* A; const bf16_t* Bt; int M, N, K; };

struct StaticOrder {
    int nM, nN, nwg, G, c;
    __host__ __device__ void init(int M, int N, int G_, int c_) { nM = M / BM; nN = N / BM; nwg = nM * nN; G = G_; c = c_; }
    __host__ __device__ bool next(int i, Unit& u) const {
        const long L = (long)i * G + c; if (L >= nwg) return false;
        int wgid = (int)L; { const int q = nwg / NXCD, r = nwg % NXCD, xcd = wgid % NXCD, off = wgid / NXCD; wgid = (xcd < r ? xcd * (q + 1) : r * (q + 1) + (xcd - r) * q) + off; }
        const int nig = WGM * nN, gid = wgid / nig, fm = gid * WGM, gsz = (nM - fm) < WGM ? (nM - fm) : WGM;
        u.pm = fm + ((wgid % nig) % gsz); u.pn = (wgid % nig) / gsz; return true;
    }
    __device__ __forceinline__ void a_ready(const Unit&) const {}
    __device__ __forceinline__ void done(const Unit&) const {}
};

__device__ __forceinline__ unsigned cvt_pk_bf16(float lo, float hi) { unsigned r; asm volatile("v_cvt_pk_bf16_f32 %0, %1, %2" : "=v"(r) : "v"(lo), "v"(hi)); return r; }
struct EpiBf16 {
    static constexpr bool PERM = true, AFTER_DRAIN = false;
    bf16_t* O; int ldc; int act;
    __device__ __forceinline__ void operator()(const f32x4 (&acc)[2][2][4][2], const Unit& u, int wr, int wc, int fr, int fq) const {
        const int row0 = u.pm * BM + wr * 64 + fr; const int col0 = u.pn * BM + wc * 32 + 8 * fq;
#pragma unroll
        for (int ai = 0; ai < 2; ++ai)
#pragma unroll
            for (int m = 0; m < 4; ++m) { bf16_t* rowp = O + (size_t)(row0 + ai * HALF + m * 16) * ldc + col0;
#pragma unroll
                for (int bj = 0; bj < 2; ++bj) { f32x4 v0 = acc[ai][bj][m][0], v1 = acc[ai][bj][m][1];
                    if (act == 2) {
#pragma unroll
                        for (int q = 0; q < 4; ++q) { const float a = v0[q] > 0.f ? v0[q] : 0.f, b = v1[q] > 0.f ? v1[q] : 0.f; v0[q] = a * a; v1[q] = b * b; } }
                    u32x4 w; w.x = cvt_pk_bf16(v0[0], v0[1]); w.y = cvt_pk_bf16(v0[2], v0[3]); w.z = cvt_pk_bf16(v1[0], v1[1]); w.w = cvt_pk_bf16(v1[2], v1[3]);
                    *(u32x4*)(rowp + bj * HALF) = w; } }
    }
};
template <class Epi, class Sched, bool ALIGN_EPI = false, bool SP2 = false>
__device__ __forceinline__ void gemm_phase(PG8_LAS unsigned char* lds, const Gemm g, const Sched& S, const Epi& E) {
    const int tid = threadIdx.x, wid = __builtin_amdgcn_readfirstlane(tid >> 6), lane = tid & 63, wr = wid >> 2, wc = wid & 3, fr = lane & 15, fq = lane >> 4;
    const int K = g.K, nt = K / BK;
    unsigned voffA[2], voffB[2];
#pragma unroll
    for (int i = 0; i < 2; ++i) { int R, C; stage_rc(tid * 16 + i * 8192, R, C); const int Rb = Epi::PERM ? ((R & ~31) + perm32(R & 31)) : R;
        voffA[i] = (unsigned)(R * K + C) * 2u; voffB[i] = (unsigned)(Rb * K + C) * 2u; }
    const size_t kstep = (size_t)(BK * 2);
    const size_t hstep = (size_t)HALF * K * 2;
    const size_t tstep = 2 * hstep;
    const unsigned ldsw = (unsigned)wid * 1024u;
    const int aoff = lds_byte(wr * 64 + fr, fq * 8), boff = lds_byte(wc * 32 + fr, fq * 8);
#define PG8_SA(b, h) (((b) * 2 + (h)) * HTB)
#define PG8_SB(b, h) ((4 + (b) * 2 + (h)) * HTB)
#define PG8_STAGE(bufoff, gbase, voff) do { _Pragma("unroll") for (int _i = 0; _i < 2; ++_i) \
        __builtin_amdgcn_global_load_lds((const unsigned*)((const char*)(gbase) + (voff)[_i]), (PG8_LAS unsigned*)(lds + (bufoff) + ldsw + _i * 8192), 16, 0, 0); } while (0)
#define PG8_LDA(dst, b, h) do { _Pragma("unroll") for (int m = 0; m < 4; ++m) _Pragma("unroll") for (int k = 0; k < 2; ++k) dst[m][k] = *(const PG8_LAS bf16x8*)(lds + PG8_SA(b, h) + aoff + m * 2048 + k * 1024); } while (0)
#define PG8_LDB(dst, b, h) do { _Pragma("unroll") for (int n = 0; n < 2; ++n) _Pragma("unroll") for (int k = 0; k < 2; ++k) dst[n][k] = *(const PG8_LAS bf16x8*)(lds + PG8_SB(b, h) + boff + n * 2048 + k * 1024); } while (0)
#define PG8_MMA(ai, bj, At, Bt) do { __builtin_amdgcn_s_setprio(1); _Pragma("unroll") for (int m = 0; m < 4; ++m) _Pragma("unroll") for (int n = 0; n < 2; ++n) _Pragma("unroll") for (int k = 0; k < 2; ++k) \
        acc[ai][bj][m][n] = __builtin_amdgcn_mfma_f32_16x16x32_bf16(Bt[n][k], At[m][k], acc[ai][bj][m][n], 0, 0, 0); __builtin_amdgcn_s_setprio(0); } while (0)
#define PG8_WAIT_V(n) asm volatile("s_waitcnt vmcnt(" #n ")" ::: "memory")
#define PG8_WAIT_L(n) asm volatile("s_waitcnt lgkmcnt(" #n ")" ::: "memory")
#define PG8_BAR __builtin_amdgcn_s_barrier()
#define PG8_SCHED __builtin_amdgcn_sched_barrier(0)
    Unit cur, nxt; int ui = 0;
    if (!S.next(0, cur)) return;
    f32x4 acc[2][2][4][2];
#pragma unroll
    for (int a = 0; a < 2; ++a)
#pragma unroll
        for (int b = 0; b < 2; ++b)
#pragma unroll
            for (int m = 0; m < 4; ++m)
#pragma unroll
                for (int n = 0; n < 2; ++n) acc[a][b][m][n] = (f32x4){0.f, 0.f, 0.f, 0.f};
    bf16x8 At[4][2], B0[2][2], B1[2][2];
    const char* cA = (const char*)g.A + (size_t)cur.pm * tstep; const char* cB = (const char*)g.Bt + (size_t)cur.pn * tstep;
    S.a_ready(cur);
    if constexpr (SP2) {
        PG8_STAGE(PG8_SB(0, 0), cB, voffB); PG8_STAGE(PG8_SB(0, 1), cB + hstep, voffB); PG8_STAGE(PG8_SA(0, 0), cA, voffA); PG8_STAGE(PG8_SA(0, 1), cA + hstep, voffA);
        if (wr == 1) PG8_BAR;
        PG8_WAIT_V(2); PG8_BAR;
        PG8_STAGE(PG8_SB(1, 0), cB + kstep, voffB); PG8_STAGE(PG8_SA(1, 0), cA + kstep, voffA); PG8_STAGE(PG8_SB(1, 1), cB + hstep + kstep, voffB);
        PG8_WAIT_V(6); PG8_BAR;
    } else {
        PG8_STAGE(PG8_SB(0, 0), cB, voffB); PG8_STAGE(PG8_SA(0, 0), cA, voffA); PG8_STAGE(PG8_SB(0, 1), cB + hstep, voffB); PG8_STAGE(PG8_SA(0, 1), cA + hstep, voffA);
        if (wr == 1) PG8_BAR;
        PG8_WAIT_V(4); PG8_BAR;
        PG8_STAGE(PG8_SB(1, 0), cB + kstep, voffB); PG8_STAGE(PG8_SA(1, 0), cA + kstep, voffA); PG8_STAGE(PG8_SB(1, 1), cB + hstep + kstep, voffB);
        PG8_WAIT_V(6); PG8_BAR;
    }
    for (;;) {
        const bool has_next = S.next(ui + 1, nxt);
        const char* nA = has_next ? (const char*)g.A + (size_t)nxt.pm * tstep : cA; const char* nB = has_next ? (const char*)g.Bt + (size_t)nxt.pn * tstep : cB;
        for (int t = 0; t < nt; t += 2) {
            const bool last = (t == nt - 2);
            const char* a1 = cA + (size_t)(t + 1) * kstep;
            const char* a2 = last ? nA : cA + (size_t)(t + 2) * kstep; const char* b2 = last ? nB : cB + (size_t)(t + 2) * kstep;
            const char* a3 = a2 + kstep; const char* b3 = b2 + kstep;
            if (last && has_next) S.a_ready(nxt);
            if constexpr (SP2) {
            PG8_LDB(B0, 0, 0); PG8_LDB(B1, 0, 1); PG8_SCHED; PG8_LDA(At, 0, 0); PG8_STAGE(PG8_SA(1, 1), a1 + hstep, voffA);
            PG8_WAIT_V(8); PG8_WAIT_L(0); PG8_BAR; PG8_MMA(0, 0, At, B0); PG8_MMA(0, 1, At, B1); PG8_BAR; PG8_SCHED;
            PG8_LDA(At, 0, 1); PG8_STAGE(PG8_SB(0, 0), b2, voffB); PG8_STAGE(PG8_SB(0, 1), b2 + hstep, voffB); PG8_STAGE(PG8_SA(0, 0), a2, voffA);
            PG8_WAIT_V(8); PG8_WAIT_L(0); PG8_BAR; PG8_MMA(1, 0, At, B0); PG8_MMA(1, 1, At, B1); PG8_BAR; PG8_SCHED;
            PG8_LDB(B0, 1, 0); PG8_LDB(B1, 1, 1); PG8_SCHED; PG8_LDA(At, 1, 0); PG8_STAGE(PG8_SA(0, 1), a2 + hstep, voffA);
            PG8_WAIT_V(8); PG8_WAIT_L(0); PG8_BAR; PG8_MMA(0, 0, At, B0); PG8_MMA(0, 1, At, B1); PG8_BAR; PG8_SCHED;
            PG8_LDA(At, 1, 1); PG8_STAGE(PG8_SB(1, 0), b3, voffB); PG8_STAGE(PG8_SB(1, 1), b3 + hstep, voffB); PG8_STAGE(PG8_SA(1, 0), a3, voffA);
            PG8_WAIT_V(8); PG8_WAIT_L(0); PG8_BAR; PG8_MMA(1, 0, At, B0); PG8_MMA(1, 1, At, B1); PG8_BAR; PG8_SCHED;
            } else {
            PG8_LDB(B0, 0, 0); PG8_SCHED; PG8_LDA(At, 0, 0); PG8_STAGE(PG8_SA(1, 1), a1 + hstep, voffA);
            PG8_WAIT_L(8); PG8_BAR; PG8_WAIT_L(0); PG8_MMA(0, 0, At, B0); PG8_BAR; PG8_SCHED;
            PG8_LDB(B1, 0, 1); PG8_STAGE(PG8_SB(0, 0), b2, voffB);
            PG8_BAR; PG8_WAIT_L(0); PG8_MMA(0, 1, At, B1); PG8_BAR;
            PG8_LDA(At, 0, 1); PG8_STAGE(PG8_SA(0, 0), a2, voffA);
            PG8_BAR; PG8_WAIT_L(0); PG8_MMA(1, 0, At, B0); PG8_BAR; PG8_SCHED;
            PG8_STAGE(PG8_SB(0, 1), b2 + hstep, voffB);
            PG8_WAIT_V(6); PG8_BAR; PG8_MMA(1, 1, At, B1); PG8_BAR;
            PG8_LDB(B0, 1, 0); PG8_SCHED; PG8_LDA(At, 1, 0); PG8_STAGE(PG8_SA(0, 1), a2 + hstep, voffA);
            PG8_WAIT_L(8); PG8_BAR; PG8_WAIT_L(0); PG8_MMA(0, 0, At, B0); PG8_BAR; PG8_SCHED;
            PG8_LDB(B1, 1, 1); PG8_STAGE(PG8_SB(1, 0), b3, voffB);
            PG8_BAR; PG8_WAIT_L(0); PG8_MMA(0, 1, At, B1); PG8_BAR;
            PG8_LDA(At, 1, 1); PG8_STAGE(PG8_SA(1, 0), a3, voffA);
            PG8_BAR; PG8_WAIT_L(0); PG8_MMA(1, 0, At, B0); PG8_BAR; PG8_SCHED;
            PG8_STAGE(PG8_SB(1, 1), b3 + hstep, voffB);
            PG8_WAIT_V(6); PG8_BAR; PG8_MMA(1, 1, At, B1); PG8_BAR;
            }
        }
        if constexpr (ALIGN_EPI) { if (wr == 0) PG8_BAR; }
        if constexpr (!Epi::AFTER_DRAIN) { E(acc, cur, wr, wc, fr, fq); S.done(cur); }
        if (!has_next) break;
#pragma unroll
        for (int a = 0; a < 2; ++a)
#pragma unroll
            for (int b = 0; b < 2; ++b)
#pragma unroll
                for (int m = 0; m < 4; ++m)
#pragma unroll
                    for (int n = 0; n < 2; ++n) acc[a][b][m][n] = (f32x4){0.f, 0.f, 0.f, 0.f};
        cur = nxt; cA = nA; cB = nB; ++ui;
        if constexpr (ALIGN_EPI) { if (wr == 1) PG8_BAR; }
    }
    PG8_WAIT_V(0);
    if constexpr (!ALIGN_EPI) { if (wr == 0) PG8_BAR; }
    PG8_BAR;
    if constexpr (Epi::AFTER_DRAIN) { E.fused(acc, cur, wr, wc, fr, fq, lds, wid, lane); S.done(cur); }
#undef PG8_SA
#undef PG8_SB
#undef PG8_STAGE
#undef PG8_LDA
#undef PG8_LDB
#undef PG8_MMA
#undef PG8_WAIT_V
#undef PG8_WAIT_L
#undef PG8_BAR
#undef PG8_SCHED
}
}

constexpr int NWAVES = 8;
#ifndef ONE_LAUNCH
#define ONE_LAUNCH 1
#endif
constexpr int BATCH = 2, SEQ = 8192, D = 1024, M = BATCH * SEQ, DEPTH = 2, MEMLEN = 256, FF = 4096;
constexpr int INW = 3200, INWP = 3328;
constexpr int ZVB = 0, ZUB = 256, ZQA = 512, ZKA = 896, ZVA = 1280, ZQC = 1664, ZKC = 2048, ZVC = 2432, ZGC = 2816;
constexpr int MIX_A = 0, MIX_B = 384, MIX_C = 640;
constexpr float EPS = 1e-6f;
constexpr int NPH_LAYER = 14, NPH = DEPTH * NPH_LAYER;

constexpr size_t MiB = 1u << 20;
constexpr size_t WS_CTL = 0, CTL_ZERO_BYTES = 1 * MiB;
constexpr size_t WS_WIN = 1 * MiB, WS_WOUT = 8 * MiB, WS_WQ = 10 * MiB, WS_WKV = 12 * MiB, WS_WO = 16 * MiB, WS_WUP = 18 * MiB, WS_WDN = 26 * MiB;
constexpr size_t WS_COS = 34 * MiB, WS_SIN = 36 * MiB;
constexpr size_t WS_MKV = 38 * MiB;
constexpr size_t WS_MEMN = 40 * MiB;
constexpr size_t WS_KV = 44 * MiB;
constexpr size_t WS_XN = 56 * MiB;
constexpr size_t WS_MIX = 88 * MiB;
constexpr size_t WS_Z = 120 * MiB;
constexpr size_t WS_Y = 120 * MiB, WS_Q = 152 * MiB, WS_H = 120 * MiB;
constexpr size_t WS_END = 248 * MiB;
constexpr int CW_TMO = 0, CW_CODE = 1, CW_BAR = 4096;

constexpr int RING_OFF = 0, RING_BYTES = 131072;
constexpr int LDSCTL_OFF = RING_BYTES, MISC_OFF = LDSCTL_OFF + 320;
constexpr int LDS_BYTES = 147456;
#define GAS __attribute__((address_space(1)))
#define LAS __attribute__((address_space(3)))
typedef unsigned short bf16;
typedef unsigned v4u __attribute__((ext_vector_type(4)));
typedef float f32x4 __attribute__((ext_vector_type(4)));
typedef short bf16x8 __attribute__((ext_vector_type(8)));
typedef GAS unsigned gu32;
typedef GAS unsigned long long gu64;
#define RLX_AGENT __ATOMIC_RELAXED, __HIP_MEMORY_SCOPE_AGENT
#define LDS_WAIT() asm volatile("s_waitcnt lgkmcnt(0)" ::: "memory")
#define VM_WAIT() asm volatile("s_waitcnt vmcnt(0)" ::: "memory")
__device__ __forceinline__ unsigned long long rt() { return __builtin_amdgcn_s_memrealtime(); }
__device__ __forceinline__ unsigned f2bf(float f) { unsigned u = __builtin_bit_cast(unsigned, f); return (u + 0x7fffu + ((u >> 16) & 1u)) >> 16; }
__device__ __forceinline__ unsigned pk2(float lo, float hi) { return f2bf(lo) | (f2bf(hi) << 16); }
#define XB_TMO      128
#define XB_XCNT(j)  (256  + 64 * (j))
#define XB_XSUB(j)  (1280 + 64 * (j))
#define XB_XGEN(j)  (2304 + 64 * (j))
#define XB_TOP      3328
#define XB_TOPGEN   3392
#define XCD_BAR_WORDS 3456
#define XB_SPIN_CAP (1u << 18)

__device__ __forceinline__ unsigned xb_ld(unsigned* p)              { return __hip_atomic_load(p, __ATOMIC_RELAXED, __HIP_MEMORY_SCOPE_AGENT); }
__device__ __forceinline__ unsigned xb_add(unsigned* p, unsigned v) { return __hip_atomic_fetch_add(p, v, __ATOMIC_RELAXED, __HIP_MEMORY_SCOPE_AGENT); }
__device__ __forceinline__ unsigned xb_xcc_id() { return (unsigned)__builtin_amdgcn_s_getreg((3 << 11) | 20) & 0xFu; }
#define XB_SPIN(cond, bar) do { unsigned _sp = 0; while (cond) { __builtin_amdgcn_s_sleep(1); \
    if ((++_sp & 255u) == 0u) { if (xb_ld(&(bar)[XB_TMO])) break; if (_sp > XB_SPIN_CAP) { atomicAdd(&(bar)[XB_TMO], 1u); break; } } } } while (0)

struct XcdBarrier {
    unsigned* bar; unsigned x;
    volatile LAS unsigned* st;
};

__device__ __forceinline__ XcdBarrier xcd_barrier_post(unsigned* bar, volatile LAS unsigned* st) {
    XcdBarrier b; b.bar = bar; b.x = xb_xcc_id(); b.st = st;
    if (threadIdx.x == 0) (void)xb_add(&bar[XB_XCNT(b.x)], 1u);
    return b;
}
__device__ __forceinline__ void xcd_barrier_complete(unsigned* bar, unsigned x, unsigned& nloc, unsigned& nx) {
    const unsigned G = gridDim.x * gridDim.y * gridDim.z;
    unsigned sum, cnt, mine, sp = 0u;
    for (;;) {
        sum = 0u; cnt = 0u; mine = 0u;
#pragma unroll
        for (unsigned j = 0; j < 16; ++j) { const unsigned c = xb_ld(&bar[XB_XCNT(j)]); sum += c; cnt += (c > 0u) ? 1u : 0u; mine = (j == x) ? c : mine; }
        if (sum == G) break;
        __builtin_amdgcn_s_sleep(1);
        if ((++sp & 255u) == 0u) { if (xb_ld(&bar[XB_TMO])) break; if (sp > XB_SPIN_CAP) { atomicAdd(&bar[XB_TMO], 1u); break; } }
    }
    nloc = mine > 0u ? mine : 1u; nx = cnt > 0u ? cnt : 1u;
}

__device__ __forceinline__ void xcd_barrier(const XcdBarrier& b) {
    asm volatile("s_waitcnt vmcnt(0)" ::: "memory");
    __syncthreads();
    if (threadIdx.x == 0) {
        unsigned* bar = b.bar;
        __builtin_amdgcn_s_waitcnt(0);
        unsigned nloc = b.st[0], nx = b.st[1];
        if (nloc == 0u) { xcd_barrier_complete(bar, b.x, nloc, nx); b.st[0] = nloc; b.st[1] = nx; }
        const unsigned old = xb_add(&bar[XB_XSUB(b.x)], 1u);
        const unsigned gen = old / nloc;
        if (old + 1u == (gen + 1u) * nloc) {
            __builtin_amdgcn_fence(__ATOMIC_RELEASE, "agent");
            asm volatile("s_waitcnt vmcnt(0)" ::: "memory");
            const unsigned og = xb_add(&bar[XB_TOP], 1u);
            const unsigned tg = og / nx;
            if (og + 1u == (tg + 1u) * nx) xb_add(&bar[XB_TOPGEN], 1u);
            else XB_SPIN(xb_ld(&bar[XB_TOPGEN]) == tg, bar);
            __builtin_amdgcn_fence(__ATOMIC_ACQUIRE, "agent");
            xb_add(&bar[XB_XGEN(b.x)], 1u);
            asm volatile("s_waitcnt vmcnt(0)" ::: "memory");
        } else {
            XB_SPIN(xb_ld(&bar[XB_XGEN(b.x)]) == gen, bar);
            __builtin_amdgcn_fence(__ATOMIC_ACQUIRE, "agent");
            asm volatile("s_waitcnt vmcnt(0)" ::: "memory");
        }
    }
    __syncthreads();
}
__device__ __forceinline__ float wave_sum(float v) {
#pragma unroll
    for (int o = 1; o < 64; o <<= 1) v += __shfl_xor(v, o);
    return v;
}

__device__ __forceinline__ float bf_lo(unsigned w) { return __uint_as_float(w << 16); }
__device__ __forceinline__ float bf_hi(unsigned w) { return __uint_as_float(w & 0xffff0000u); }
__device__ __forceinline__ float bf1(bf16 h) { return __uint_as_float((unsigned)h << 16); }
__device__ __forceinline__ float gelu_tanh(float x) {
    const float u = 0.7978845608028654f * (x + 0.044715f * x * x * x);
    const float e = __expf(2.f * u);
    const float t = 1.f - 2.f / (e + 1.f);
    return 0.5f * x * (1.f + t);
}
__device__ __forceinline__ float dot8(const v4u a, const float* q) {
    return q[0] * bf_lo(a.x) + q[1] * bf_hi(a.x) + q[2] * bf_lo(a.y) + q[3] * bf_hi(a.y) + q[4] * bf_lo(a.z) + q[5] * bf_hi(a.z) + q[6] * bf_lo(a.w) + q[7] * bf_hi(a.w);
}
__device__ __forceinline__ void unpack8(const v4u a, float* f) {
    f[0] = bf_lo(a.x); f[1] = bf_hi(a.x); f[2] = bf_lo(a.y); f[3] = bf_hi(a.y); f[4] = bf_lo(a.z); f[5] = bf_hi(a.z); f[6] = bf_lo(a.w); f[7] = bf_hi(a.w);
}
__device__ __forceinline__ int win_row(int n0) { return n0 < 1152 ? n0 + 512 : (n0 < 1408 ? n0 - 896 : (n0 < 1664 ? n0 - 1408 : n0)); }

__device__ __forceinline__ void tr_item(const float* W, int K, int N, bf16* WT, int mode, LAS float* scr, int item, int lane) {
    const int nblk = N / 32, kb = item / nblk, nb = item % nblk, k0 = 64 * kb, n0 = 32 * nb;
    const int rb = mode ? win_row(n0) : n0;
#pragma unroll 8
    for (int i = 0; i < 32; ++i) { const int kk = 2 * i + (lane >> 5); scr[kk * 33 + (lane & 31)] = W[(size_t)(k0 + kk) * N + n0 + (lane & 31)]; }
    LDS_WAIT(); asm volatile("" ::: "memory");
    const int c = lane & 7;
#pragma unroll
    for (int j = 0; j < 4; ++j) { const int n = (lane >> 3) + 8 * j; const LAS float* s = scr + (8 * c) * 33 + n;
        v4u o; o.x = pk2(s[0 * 33], s[1 * 33]); o.y = pk2(s[2 * 33], s[3 * 33]); o.z = pk2(s[4 * 33], s[5 * 33]); o.w = pk2(s[6 * 33], s[7 * 33]);
        *(GAS v4u*)(WT + (size_t)(rb + n) * K + k0 + 8 * c) = o; }
    LDS_WAIT(); asm volatile("" ::: "memory");
}
__device__ __forceinline__ void rms_row_to_bf16(const float* xrow, const float* g, bf16* orow, int lane) {
    const GAS f32x4* xr = (const GAS f32x4*)xrow + lane; const GAS f32x4* gr = (const GAS f32x4*)g + lane;
    f32x4 v[4]; float s = 0.f;
#pragma unroll
    for (int j = 0; j < 4; ++j) { v[j] = xr[64 * j]; s += (v[j].x * v[j].x + v[j].y * v[j].y) + (v[j].z * v[j].z + v[j].w * v[j].w); }
    const float r = 1.f / sqrtf(wave_sum(s) * (1.f / D) + EPS);
    GAS unsigned long long* o8 = (GAS unsigned long long*)orow + lane;
#pragma unroll
    for (int j = 0; j < 4; ++j) { const f32x4 gg = gr[64 * j]; o8[64 * j] = (unsigned long long)pk2(v[j].x * r * gg.x, v[j].y * r * gg.y) | ((unsigned long long)pk2(v[j].z * r * gg.z, v[j].w * r * gg.w) << 32); }
}
__device__ __forceinline__ void res_row(const float* xin, const bf16* y, const float* gpost, const float* gpre, float* xout, bf16* xn, int lane) {
    const GAS unsigned long long* yr = (const GAS unsigned long long*)y + lane;
    f32x4 yv[4]; float s = 0.f;
#pragma unroll
    for (int j = 0; j < 4; ++j) { const unsigned long long w = yr[64 * j]; const unsigned lo = (unsigned)w, hi = (unsigned)(w >> 32);
        yv[j] = (f32x4){bf_lo(lo), bf_hi(lo), bf_lo(hi), bf_hi(hi)}; s += (yv[j].x * yv[j].x + yv[j].y * yv[j].y) + (yv[j].z * yv[j].z + yv[j].w * yv[j].w); }
    const float r = 1.f / sqrtf(wave_sum(s) * (1.f / D) + EPS);
    f32x4 xv[4]; float s2 = 0.f;
#pragma unroll
    for (int j = 0; j < 4; ++j) { const f32x4 gg = ((const GAS f32x4*)gpost + lane)[64 * j]; const f32x4 xi = ((const GAS f32x4*)xin + lane)[64 * j];
        xv[j] = xi + yv[j] * r * gg; ((GAS f32x4*)xout + lane)[64 * j] = xv[j];
        s2 += (xv[j].x * xv[j].x + xv[j].y * xv[j].y) + (xv[j].z * xv[j].z + xv[j].w * xv[j].w); }
    if (gpre) {
        const float r2 = 1.f / sqrtf(wave_sum(s2) * (1.f / D) + EPS);
        GAS unsigned long long* o8 = (GAS unsigned long long*)xn + lane;
#pragma unroll
        for (int j = 0; j < 4; ++j) { const f32x4 gg = ((const GAS f32x4*)gpre + lane)[64 * j];
            o8[64 * j] = (unsigned long long)pk2(xv[j].x * r2 * gg.x, xv[j].y * r2 * gg.y) | ((unsigned long long)pk2(xv[j].z * r2 * gg.z, xv[j].w * r2 * gg.w) << 32); }
    }
}

__device__ __forceinline__ void dil_naive_task(const bf16* Z, bf16* MIX, int task, int tid) {
    const int blk = task & 15, bh = task >> 4, h = bh % 6, b = bh / 6;
    const int pos = blk * 512 + tid; const size_t row = (size_t)b * SEQ + pos;
    float q[64], o[64];
    { const GAS v4u* qp = (const GAS v4u*)(Z + row * INWP + ZQA + h * 64);
#pragma unroll
      for (int c = 0; c < 8; ++c) { const v4u w = qp[c]; unpack8(w, q + 8 * c); }
#pragma unroll
      for (int e = 0; e < 64; ++e) { q[e] *= 0.125f; o[e] = 0.f; } }
    float mx = -INFINITY, l = 0.f;
    for (int br = 0; br < 3; ++br) {
        const int d = br == 0 ? 1 : (br == 1 ? 4 : 16);
        for (int j = 0; j <= 128; ++j) {
            const int kp = pos - j * d; if (kp < 0) break;
            const size_t krow = (size_t)b * SEQ + kp;
            const GAS v4u* kr = (const GAS v4u*)(Z + krow * INWP + ZKA + h * 64);
            const GAS v4u* vr = (const GAS v4u*)(Z + krow * INWP + ZVA + h * 64);
            float s = 0.f;
#pragma unroll
            for (int c = 0; c < 8; ++c) s += dot8(kr[c], q + 8 * c);
            const float mn = fmaxf(mx, s), corr = __expf(mx - mn), p = __expf(s - mn);
            l = l * corr + p; mx = mn;
#pragma unroll
            for (int c = 0; c < 8; ++c) { float vv[8]; unpack8(vr[c], vv);
#pragma unroll
                for (int e = 0; e < 8; ++e) o[8 * c + e] = o[8 * c + e] * corr + p * vv[e]; }
        }
    }
    const float il = 1.f / l;
    GAS v4u* op = (GAS v4u*)(MIX + row * D + MIX_A + h * 64);
#pragma unroll
    for (int c = 0; c < 8; ++c) { v4u w; w.x = pk2(o[8 * c] * il, o[8 * c + 1] * il); w.y = pk2(o[8 * c + 2] * il, o[8 * c + 3] * il); w.z = pk2(o[8 * c + 4] * il, o[8 * c + 5] * il); w.w = pk2(o[8 * c + 6] * il, o[8 * c + 7] * il); op[c] = w; }
}
__device__ __forceinline__ void sgu_naive_task(const bf16* Z, bf16* MIX, const float* sw, const float* sb, const float* lng, const float* lnb, LAS unsigned char* lds, int task, int tid) {
    LAS float* vn = (LAS float*)lds; const int lane = tid & 63, wave = tid >> 6; const size_t row0 = (size_t)task * 128;
    for (int i = wave; i < 128; i += NWAVES) {
        const GAS unsigned long long* vp = (const GAS unsigned long long*)(Z + (row0 + i) * INWP + ZVB) + lane;
        const unsigned long long w = *vp; const unsigned lo = (unsigned)w, hi = (unsigned)(w >> 32);
        float v[4] = {gelu_tanh(bf_lo(lo)), gelu_tanh(bf_hi(lo)), gelu_tanh(bf_lo(hi)), gelu_tanh(bf_hi(hi))};
        const float mu = wave_sum((v[0] + v[1]) + (v[2] + v[3])) * (1.f / 256.f);
        float q = 0.f;
#pragma unroll
        for (int c = 0; c < 4; ++c) { v[c] -= mu; q += v[c] * v[c]; }
        const float rs = 1.f / sqrtf(wave_sum(q) * (1.f / 256.f) + EPS);
#pragma unroll
        for (int c = 0; c < 4; ++c) vn[i * 256 + 4 * lane + c] = v[c] * rs * lng[4 * lane + c] + lnb[4 * lane + c];
    }
    __syncthreads();
    const int ch = tid & 255, g = ch >> 6;
    for (int i = tid >> 8; i < 128; i += 2) {
        const float* wr = sw + ((size_t)g * 128 + i) * 128;
        float s = 0.f;
        for (int j = 0; j <= i; ++j) s += wr[j] * vn[j * 256 + ch];
        s += sb[g * 128 + i];
        const float u = gelu_tanh(bf1(Z[(row0 + i) * INWP + ZUB + ch]));
        MIX[(row0 + i) * D + MIX_B + ch] = (bf16)f2bf(u * s);
    }
    __syncthreads();
}
__device__ __forceinline__ float rot_elem(const bf16* raw, const float* cs, const float* sn, int e) {
    const int j = e & 31; const float t1 = bf1(raw[j]), t2 = bf1(raw[j + 32]), c = cs[j], s = sn[j];
    return e < 32 ? t1 * c - t2 * s : t2 * c + t1 * s;
}
__device__ __forceinline__ void ret1_naive_task(const bf16* Z, const float* COS, const float* SIN, float* KV, LAS unsigned char* lds, int task, int tid) {
    const int h = task % 6, bn = task / 6, n = bn & 63, b = bn >> 6; const size_t row0 = (size_t)b * SEQ + n * 128;
    LAS float* kr = (LAS float*)lds; LAS float* vv = kr + 128 * 64;
    const float logg = log1pf(-exp2f(-5.f - (float)h));
    for (int idx = tid; idx < 128 * 64; idx += NWAVES * 64) {
        const int j = idx >> 6, e = idx & 63; const size_t row = row0 + j;
        kr[idx] = rot_elem(Z + row * INWP + ZKC + h * 64, COS + row * 32, SIN + row * 32, e) * 0.125f * __expf((float)(127 - j) * logg);
        vv[idx] = bf1(Z[row * INWP + ZVC + h * 64 + e]);
    }
    __syncthreads();
    const int e1 = tid >> 3, e2 = (tid & 7) * 8;
    float a[8] = {0.f, 0.f, 0.f, 0.f, 0.f, 0.f, 0.f, 0.f};
    for (int j = 0; j < 128; ++j) { const float k = kr[j * 64 + e1];
#pragma unroll
        for (int c = 0; c < 8; ++c) a[c] += k * vv[j * 64 + e2 + c]; }
    float* out = KV + (((size_t)(b * 6 + h) * 64 + n) * 64 + e1) * 64 + e2;
#pragma unroll
    for (int c = 0; c < 8; ++c) out[c] = a[c];
    __syncthreads();
}
__device__ __forceinline__ void ret2_naive_task(const bf16* Z, const float* COS, const float* SIN, const float* KV, bf16* MIX, LAS unsigned char* lds, int task, int tid) {
    const int h = task % 6, bn = task / 6, n = bn & 63, b = bn >> 6; const size_t row0 = (size_t)b * SEQ + n * 128;
    LAS float* kr = (LAS float*)lds; LAS float* vv = kr + 128 * 64; LAS float* pv = vv + 128 * 64;
    const float logg = log1pf(-exp2f(-5.f - (float)h));
    for (int idx = tid; idx < 128 * 64; idx += NWAVES * 64) {
        const int j = idx >> 6, e = idx & 63; const size_t row = row0 + j;
        kr[idx] = rot_elem(Z + row * INWP + ZKC + h * 64, COS + row * 32, SIN + row * 32, e) * 0.125f;
        vv[idx] = bf1(Z[row * INWP + ZVC + h * 64 + e]);
    }
    { const float* prev = KV + ((size_t)(b * 6 + h) * 64 + n) * 4096;
      for (int idx = tid; idx < 4096; idx += NWAVES * 64) pv[idx] = prev[idx]; }
    __syncthreads();
    const int i = tid >> 2, qt = tid & 3, e0 = qt * 16; const size_t row = row0 + i;
    float q[64], y[16];
#pragma unroll
    for (int e = 0; e < 64; ++e) q[e] = rot_elem(Z + row * INWP + ZQC + h * 64, COS + row * 32, SIN + row * 32, e);
#pragma unroll
    for (int c = 0; c < 16; ++c) y[c] = 0.f;
    const int imax = (tid | 63) >> 2;
    for (int j = 0; j <= imax; ++j) {
        if (j <= i) {
            float s = 0.f;
#pragma unroll
            for (int e = 0; e < 64; ++e) s += q[e] * kr[j * 64 + e];
            s *= __expf((float)(i - j) * logg);
#pragma unroll
            for (int c = 0; c < 16; ++c) y[c] += s * vv[j * 64 + e0 + c];
        }
    }
    { const float qd = __expf((float)(i + 1) * logg);
#pragma unroll
      for (int e1 = 0; e1 < 64; ++e1) { const float a = q[e1] * qd;
#pragma unroll
          for (int c = 0; c < 16; ++c) y[c] += a * pv[e1 * 64 + e0 + c]; } }
    float s = 0.f;
#pragma unroll
    for (int c = 0; c < 16; ++c) s += y[c];
    s += __shfl_xor(s, 1); s += __shfl_xor(s, 2);
    const float mu = s * (1.f / 64.f); float v2 = 0.f;
#pragma unroll
    for (int c = 0; c < 16; ++c) { y[c] -= mu; v2 += y[c] * y[c]; }
    v2 += __shfl_xor(v2, 1); v2 += __shfl_xor(v2, 2);
    const float rs = 1.f / sqrtf(v2 * (1.f / 64.f) + EPS);
    const bf16* gp = Z + row * INWP + ZGC + h * 64 + e0; bf16* op = MIX + row * D + MIX_C + h * 64 + e0;
#pragma unroll
    for (int c = 0; c < 16; ++c) { const float g = bf1(gp[c]); const float sg = g / (1.f + __expf(-g)); op[c] = (bf16)f2bf(sg * y[c] * rs); }
    __syncthreads();
}
__device__ __forceinline__ void xattn_naive_task(const bf16* Q, const bf16* MKV, bf16* O, LAS unsigned char* lds, int task, int tid) {
    constexpr int KP = 264;
    const int h = task & 3, tile = (task >> 2) & 255, b = task >> 10; const size_t row0 = (size_t)b * SEQ + tile * 32;
    LAS bf16* kvb = (LAS bf16*)lds; LAS float* sp = (LAS float*)(lds + 128 * KP * 2);
    const int t = tid >> 4, ms = tid & 15;
    const GAS v4u* qp = (const GAS v4u*)(Q + (row0 + t) * D + h * 256);
    for (int half = 0; half < 2; ++half) {
        for (int idx = tid; idx < 128 * 32; idx += NWAVES * 64) { const int mm = idx >> 5, c = idx & 31;
            *(LAS v4u*)(kvb + mm * KP + c * 8) = *(const GAS v4u*)(MKV + (size_t)(b * 256 + half * 128 + mm) * 2048 + h * 256 + c * 8); }
        __syncthreads();
        float acc[8] = {0.f, 0.f, 0.f, 0.f, 0.f, 0.f, 0.f, 0.f};
        for (int c = 0; c < 32; ++c) { float qf[8]; unpack8(qp[c], qf);
#pragma unroll
            for (int i = 0; i < 8; ++i) acc[i] += dot8(*(const LAS v4u*)(kvb + (ms + 16 * i) * KP + c * 8), qf); }
#pragma unroll
        for (int i = 0; i < 8; ++i) sp[t * 256 + half * 128 + ms + 16 * i] = acc[i] * 0.0625f;
        __syncthreads();
    }
    { float v[16]; float mx = -INFINITY;
#pragma unroll
      for (int i = 0; i < 16; ++i) { v[i] = sp[t * 256 + ms + 16 * i]; mx = fmaxf(mx, v[i]); }
      mx = fmaxf(mx, __shfl_xor(mx, 1)); mx = fmaxf(mx, __shfl_xor(mx, 2)); mx = fmaxf(mx, __shfl_xor(mx, 4)); mx = fmaxf(mx, __shfl_xor(mx, 8));
      float sum = 0.f;
#pragma unroll
      for (int i = 0; i < 16; ++i) { v[i] = __expf(v[i] - mx); sum += v[i]; }
      sum += __shfl_xor(sum, 1); sum += __shfl_xor(sum, 2); sum += __shfl_xor(sum, 4); sum += __shfl_xor(sum, 8);
      const float is = 1.f / sum;
#pragma unroll
      for (int i = 0; i < 16; ++i) sp[t * 256 + ms + 16 * i] = v[i] * is; }
    __syncthreads();
    float o[16];
#pragma unroll
    for (int c = 0; c < 16; ++c) o[c] = 0.f;
    for (int half = 0; half < 2; ++half) {
        for (int idx = tid; idx < 128 * 32; idx += NWAVES * 64) { const int mm = idx >> 5, c = idx & 31;
            *(LAS v4u*)(kvb + mm * KP + c * 8) = *(const GAS v4u*)(MKV + (size_t)(b * 256 + half * 128 + mm) * 2048 + 1024 + h * 256 + c * 8); }
        __syncthreads();
        for (int mm = 0; mm < 128; ++mm) { const float p = sp[t * 256 + half * 128 + mm]; float vf[16];
            unpack8(*(const LAS v4u*)(kvb + mm * KP + ms * 16), vf); unpack8(*(const LAS v4u*)(kvb + mm * KP + ms * 16 + 8), vf + 8);
#pragma unroll
            for (int c = 0; c < 16; ++c) o[c] += p * vf[c]; }
        __syncthreads();
    }
    GAS v4u* op = (GAS v4u*)(O + (row0 + t) * D + h * 256 + ms * 16);
    { v4u w; w.x = pk2(o[0], o[1]); w.y = pk2(o[2], o[3]); w.z = pk2(o[4], o[5]); w.w = pk2(o[6], o[7]); op[0] = w;
      w.x = pk2(o[8], o[9]); w.y = pk2(o[10], o[11]); w.z = pk2(o[12], o[13]); w.w = pk2(o[14], o[15]); op[1] = w; }
}

struct Args { const float* in[15]; float* out; unsigned char* ws; float inv[32]; int ph_lo, ph_hi; };
typedef __attribute__((address_space(4))) const Args* KArgs;
#define WSP(T, off) ((T*)(ws + (off)))
__global__ void __launch_bounds__(NWAVES * 64, 2) mk_fwd(Args args_unused) {
    extern __shared__ __attribute__((aligned(16))) unsigned char lds_raw[];
    LAS unsigned char* lds = (LAS unsigned char*)lds_raw;
    { const int t0 = threadIdx.x; for (int u = t0; u < (LDS_BYTES - LDSCTL_OFF) / 4; u += NWAVES * 64) ((LAS unsigned*)(lds + LDSCTL_OFF))[u] = 0u; }
    __syncthreads();
    KArgs ap = (KArgs)__builtin_amdgcn_kernarg_segment_ptr();
#if ONE_LAUNCH
    XcdBarrier bar = xcd_barrier_post((unsigned*)(ap->ws + WS_CTL) + CW_BAR, (volatile LAS unsigned*)(lds + MISC_OFF) + 8);
#endif
    const int ph_lo = ap->ph_lo, ph_hi = ap->ph_hi;
    for (int ph = ph_lo; ph < ph_hi; ++ph) {
        int tid = threadIdx.x; asm volatile("" : "+v"(tid));
        asm volatile("" : "+s"(ap));
        unsigned char* ws = ap->ws;
        const int lane = tid & 63, wave = __builtin_amdgcn_readfirstlane(tid >> 6);
        const int G = gridDim.x, bx = blockIdx.x; const int vcu = (G % 8 == 0) ? (bx % 8) * (G / 8) + bx / 8 : bx;
        const int gw = vcu * NWAVES + wave, NGW = G * NWAVES;
        const int gt = vcu * NWAVES * 64 + tid, NGT = G * NWAVES * 64;
        const int l = ph / NPH_LAYER, k = ph % NPH_LAYER;
        if (k == 0) {
            LAS float* scr = (LAS float*)(lds + RING_OFF + wave * 16384);
            constexpr int I_IN = 16 * 100, I_SQ = 16 * 32, I_KV = 16 * 64, I_UP = 16 * 128, I_DN = 64 * 32;
            constexpr int NITEMS = I_IN + 3 * I_SQ + I_KV + I_UP + I_DN;
            for (int it = gw; it < NITEMS; it += NGW) {
                int r = it;
                if (r < I_IN) { tr_item(ap->in[4] + (size_t)l * D * INW, D, INW, WSP(bf16, WS_WIN), 1, scr, r, lane); continue; } r -= I_IN;
                if (r < I_SQ) { tr_item(ap->in[9] + (size_t)l * D * D, D, D, WSP(bf16, WS_WOUT), 0, scr, r, lane); continue; } r -= I_SQ;
                if (r < I_SQ) { tr_item(ap->in[10] + (size_t)l * D * D, D, D, WSP(bf16, WS_WQ), 0, scr, r, lane); continue; } r -= I_SQ;
                if (r < I_KV) { tr_item(ap->in[11] + (size_t)l * D * 2 * D, D, 2 * D, WSP(bf16, WS_WKV), 0, scr, r, lane); continue; } r -= I_KV;
                if (r < I_SQ) { tr_item(ap->in[12] + (size_t)l * D * D, D, D, WSP(bf16, WS_WO), 0, scr, r, lane); continue; } r -= I_SQ;
                if (r < I_UP) { tr_item(ap->in[13] + (size_t)l * D * FF, D, FF, WSP(bf16, WS_WUP), 0, scr, r, lane); continue; } r -= I_UP;
                tr_item(ap->in[14] + (size_t)l * FF * D, FF, D, WSP(bf16, WS_WDN), 0, scr, r, lane);
            }
            if (l == 0) {
                const float* x_in = ap->in[0]; const float* mem = ap->in[1]; const int* positions = (const int*)ap->in[2]; const float* norm_g = ap->in[3];
                bf16* Win_t = WSP(bf16, WS_WIN); bf16* XN = WSP(bf16, WS_XN); bf16* MEMN = WSP(bf16, WS_MEMN); float* COS = WSP(float, WS_COS); float* SIN = WSP(float, WS_SIN);
                for (int i = gt; i < (INWP - INW) * D / 8; i += NGT) ((GAS v4u*)(Win_t + (size_t)INW * D))[i] = (v4u){0u, 0u, 0u, 0u};
                for (int m = gw; m < M; m += NGW) rms_row_to_bf16(x_in + (size_t)m * D, norm_g, XN + (size_t)m * D, lane);
                for (int m = gw; m < DEPTH * 512; m += NGW) { const int ll = m >> 9, mr = m & 511;
                    rms_row_to_bf16(mem + (size_t)mr * D, norm_g + ((size_t)ll * 7 + 6) * D, MEMN + (size_t)m * D, lane); }
                for (int i = gt; i < M * 32; i += NGT) { const int j = i & 31, row = i >> 5;
                    const float ang = (float)positions[row] * ap->inv[j];
                    const double rev = (double)ang * 0.15915494309189535; const float fr = (float)(rev - rint(rev));
                    COS[i] = __builtin_amdgcn_cosf(fr); SIN[i] = __builtin_amdgcn_sinf(fr); }
            }
        } else if (k == 1 || k == 5 || k == 7 || k == 9 || k == 11 || k == 12) {
            const int ngemm = (k == 7) ? 2 : 1;
            for (int gi = 0; gi < ngemm; ++gi) {
                const bf16* gA; const bf16* gB; bf16* gO; int gM, gN, gldc, gact = 0;
                if (k == 1)       { gA = WSP(bf16, WS_XN); gB = WSP(bf16, WS_WIN); gM = M; gN = INWP; gO = WSP(bf16, WS_Z); gldc = INWP; }
                else if (k == 5)  { gA = WSP(bf16, WS_MIX); gB = WSP(bf16, WS_WOUT); gM = M; gN = D; gO = WSP(bf16, WS_Y); gldc = D; }
                else if (k == 7)  { if (gi == 0) { gA = WSP(bf16, WS_XN); gB = WSP(bf16, WS_WQ); gM = M; gN = D; gO = WSP(bf16, WS_Q); gldc = D; }
                                    else { gA = WSP(bf16, WS_MEMN) + (size_t)l * 512 * D; gB = WSP(bf16, WS_WKV); gM = 512; gN = 2 * D; gO = WSP(bf16, WS_MKV); gldc = 2 * D; } }
                else if (k == 9)  { gA = WSP(bf16, WS_MIX); gB = WSP(bf16, WS_WO); gM = M; gN = D; gO = WSP(bf16, WS_Y); gldc = D; }
                else if (k == 11) { gA = WSP(bf16, WS_XN); gB = WSP(bf16, WS_WUP); gM = M; gN = FF; gO = WSP(bf16, WS_H); gldc = FF; gact = 2; }
                else              { gA = WSP(bf16, WS_H); gB = WSP(bf16, WS_WDN); gM = M; gN = D; gO = WSP(bf16, WS_MIX); gldc = D; }
                pg8::StaticOrder S; S.init(gM, gN, G, bx);
                const pg8::EpiBf16 E{gO, gldc, gact};
                if (k == 12) pg8::gemm_phase<pg8::EpiBf16, pg8::StaticOrder, true, true>(lds + RING_OFF, pg8::Gemm{gA, gB, gM, gN, FF}, S, E);
                else         pg8::gemm_phase<pg8::EpiBf16, pg8::StaticOrder, true, true>(lds + RING_OFF, pg8::Gemm{gA, gB, gM, gN, D}, S, E);
                __syncthreads();
            }
        } else if (k == 2) {
            constexpr int T_DIL = 2 * 6 * 16, T_SGU = M / 128, T_RET = 2 * 64 * 6;
            for (int t = bx; t < T_DIL + T_SGU + T_RET; t += G) {
                if (t < T_DIL) dil_naive_task(WSP(bf16, WS_Z), WSP(bf16, WS_MIX), t, tid);
                else if (t < T_DIL + T_SGU) sgu_naive_task(WSP(bf16, WS_Z), WSP(bf16, WS_MIX), ap->in[5] + (size_t)l * 4 * 128 * 128, ap->in[6] + (size_t)l * 4 * 128, ap->in[7] + (size_t)l * 256, ap->in[8] + (size_t)l * 256, lds, t - T_DIL, tid);
                else ret1_naive_task(WSP(bf16, WS_Z), WSP(float, WS_COS), WSP(float, WS_SIN), WSP(float, WS_KV), lds, t - T_DIL - T_SGU, tid);
            }
        } else if (k == 3) {
            float* KV = WSP(float, WS_KV);
            for (int i = gt; i < 12 * 4096; i += NGT) { const int bh = i >> 12, el = i & 4095, h = bh % 6;
                const float cd = __expf(128.f * log1pf(-exp2f(-5.f - (float)h)));
                float* p = KV + (size_t)bh * 64 * 4096 + el; float st = 0.f;
                for (int n = 0; n < 64; ++n) { const float t = p[(size_t)n * 4096]; p[(size_t)n * 4096] = st; st = cd * st + t; } }
        } else if (k == 4) {
            for (int t = bx; t < 2 * 64 * 6; t += G) ret2_naive_task(WSP(bf16, WS_Z), WSP(float, WS_COS), WSP(float, WS_SIN), WSP(float, WS_KV), WSP(bf16, WS_MIX), lds, t, tid);
        } else if (k == 6 || k == 10 || k == 13) {
            const float* norm_g = ap->in[3]; const float* ng = norm_g + (size_t)l * 7 * D; float* out = ap->out;
            const float* xin = (l == 0 && k == 6) ? ap->in[0] : out;
            const bf16* y = (k == 13) ? WSP(bf16, WS_MIX) : WSP(bf16, WS_Y);
            const float* gpost = ng + (size_t)(k == 6 ? 1 : (k == 10 ? 3 : 5)) * D;
            const float* gpre = (k == 6) ? ng + 2 * D : (k == 10 ? ng + 4 * D : (l + 1 < DEPTH ? norm_g + (size_t)(l + 1) * 7 * D : nullptr));
            bf16* XN = WSP(bf16, WS_XN);
            for (int m = gw; m < M; m += NGW) res_row(xin + (size_t)m * D, y + (size_t)m * D, gpost, gpre, out + (size_t)m * D, XN + (size_t)m * D, lane);
        } else if (k == 8) {
            for (int t = bx; t < 2048; t += G) xattn_naive_task(WSP(bf16, WS_Q), WSP(bf16, WS_MKV), WSP(bf16, WS_MIX), lds, t, tid);
        }
#if ONE_LAUNCH
        if (ph + 1 < ph_hi) xcd_barrier(bar);
#endif
    }
}

extern "C" void kernel_launch(void* const* d_in, const int* in_sizes, int n_in, void* d_out, int out_size, void* d_ws, size_t ws_size, hipStream_t stream) {
    static int grid = 0;
    if (grid == 0) {
        if (n_in != 15 || out_size != M * D || ws_size < WS_END) { fprintf(stderr, "kernel_launch: unexpected shapes (n_in %d out %d ws %zu)\n", n_in, out_size, ws_size); grid = -1; return; }
        int dev = 0, cus = 0, per_cu = 0;
        if (hipGetDevice(&dev) != hipSuccess || hipDeviceGetAttribute(&cus, hipDeviceAttributeMultiprocessorCount, dev) != hipSuccess) { grid = -1; return; }
        if (hipFuncSetAttribute((const void*)mk_fwd, hipFuncAttributeMaxDynamicSharedMemorySize, LDS_BYTES) != hipSuccess) { fprintf(stderr, "kernel_launch: hipFuncSetAttribute failed\n"); grid = -1; return; }
        if (hipOccupancyMaxActiveBlocksPerMultiprocessor(&per_cu, (const void*)mk_fwd, NWAVES * 64, LDS_BYTES) != hipSuccess || per_cu < 1) { fprintf(stderr, "kernel_launch: occupancy query says %d blocks per CU\n", per_cu); }
        (void)hipGetLastError();
        grid = cus;
    }
    if (grid < 0) return;
    (void)hipMemsetAsync((char*)d_ws + WS_CTL, 0, CTL_ZERO_BYTES, stream);
    Args a{};
    for (int i = 0; i < 15; ++i) a.in[i] = (const float*)d_in[i];
    a.out = (float*)d_out; a.ws = (unsigned char*)d_ws;
    for (int j = 0; j < 32; ++j) a.inv[j] = (float)(1.0 / pow(10000.0, (double)((float)j / 31.0f)));
#if ONE_LAUNCH
    a.ph_lo = 0; a.ph_hi = NPH;
    hipLaunchKernelGGL(mk_fwd, dim3(grid), dim3(NWAVES * 64), LDS_BYTES, stream, a);
#else
    for (int p = 0; p < NPH; ++p) { a.ph_lo = p; a.ph_hi = p + 1; hipLaunchKernelGGL(mk_fwd, dim3(grid), dim3(NWAVES * 64), LDS_BYTES, stream, a); }
#endif
}
```

```cpp
#include <hip/hip_runtime.h>
#include <cstdio>
#include <cstdint>
#include <cmath>
namespace pg8 {
#define PG8_LAS __attribute__((address_space(3)))
typedef unsigned short bf16_t;
typedef short bf16x8 __attribute__((ext_vector_type(8)));
typedef float f32x4 __attribute__((ext_vector_type(4)));
typedef unsigned u32x4 __attribute__((ext_vector_type(4)));
constexpr int BM = 256, BK = 64, HALF = 128, HTB = HALF * BK * 2  , STAGE_BYTES = 8 * HTB, NXCD = 8, WGM = 8;

__host__ __device__ __forceinline__ int lds_byte(int r, int c) { const int st = (r >> 4) * 2 + (c >> 5), rr = r & 15, cc = c & 31, ob = rr * 64 + cc * 2; return st * 1024 + (ob ^ (((ob >> 9) & 1) << 5)); }
__host__ __device__ __forceinline__ void stage_rc(int b, int& R, int& C) { const int st = b / 1024, sb = b % 1024, swz = sb ^ (((sb >> 9) & 1) << 5); R = (st >> 1) * 16 + swz / 64; C = (st & 1) * 32 + (swz % 64) / 2; }
__host__ __device__ __forceinline__ int perm32(int rho) { const int n = rho >> 4, i = rho & 15; return 8 * (i >> 2) + 4 * n + (i & 3); }

struct Unit { int pm, pn; };
struct Gemm { const bf16_t* A; const bf16_t* Bt; int M, N, K; };

struct StaticOrder {
    int nM, nN, nwg, G, c;
    __host__ __device__ void init(int M, int N, int G_, int c_) { nM = M / BM; nN = N / BM; nwg = nM * nN; G = G_; c = c_; }
    __host__ __device__ bool next(int i, Unit& u) const {
        const long L = (long)i * G + c; if (L >= nwg) return false;
        int wgid = (int)L; { const int q = nwg / NXCD, r = nwg % NXCD, xcd = wgid % NXCD, off = wgid / NXCD; wgid = (xcd < r ? xcd * (q + 1) : r * (q + 1) + (xcd - r) * q) + off; }
        const int nig = WGM * nN, gid = wgid / nig, fm = gid * WGM, gsz = (nM - fm) < WGM ? (nM - fm) : WGM;
        u.pm = fm + ((wgid % nig) % gsz); u.pn = (wgid % nig) / gsz; return true;
    }
    __device__ __forceinline__ void a_ready(const Unit&) const {}
    __device__ __forceinline__ void done(const Unit&) const {}
};

__device__ __forceinline__ unsigned cvt_pk_bf16(float lo, float hi) { unsigned r; asm volatile("v_cvt_pk_bf16_f32 %0, %1, %2" : "=v"(r) : "v"(lo), "v"(hi)); return r; }
struct EpiBf16 {
    static constexpr bool PERM = true, AFTER_DRAIN = false;
    bf16_t* O; int ldc; int act;
    __device__ __forceinline__ void operator()(const f32x4 (&acc)[2][2][4][2], const Unit& u, int wr, int wc, int fr, int fq) const {
        const int row0 = u.pm * BM + wr * 64 + fr; const int col0 = u.pn * BM + wc * 32 + 8 * fq;
#pragma unroll
        for (int ai = 0; ai < 2; ++ai)
#pragma unroll
            for (int m = 0; m < 4; ++m) { bf16_t* rowp = O + (size_t)(row0 + ai * HALF + m * 16) * ldc + col0;
#pragma unroll
                for (int bj = 0; bj < 2; ++bj) { f32x4 v0 = acc[ai][bj][m][0], v1 = acc[ai][bj][m][1];
                    if (act == 2) {
#pragma unroll
                        for (int q = 0; q < 4; ++q) { const float a = v0[q] > 0.f ? v0[q] : 0.f, b = v1[q] > 0.f ? v1[q] : 0.f; v0[q] = a * a; v1[q] = b * b; } }
                    u32x4 w; w.x = cvt_pk_bf16(v0[0], v0[1]); w.y = cvt_pk_bf16(v0[2], v0[3]); w.z = cvt_pk_bf16(v1[0], v1[1]); w.w = cvt_pk_bf16(v1[2], v1[3]);
                    *(u32x4*)(rowp + bj * HALF) = w; } }
    }
};
template <class Epi, class Sched, bool ALIGN_EPI = false, bool SP2 = false>
__device__ __forceinline__ void gemm_phase(PG8_LAS unsigned char* lds, const Gemm g, const Sched& S, const Epi& E, const int tid) {
    const int wid = __builtin_amdgcn_readfirstlane(tid >> 6), lane = tid & 63, wr = wid >> 2, wc = wid & 3, fr = lane & 15, fq = lane >> 4;
    const int K = g.K, nt = K / BK;
    unsigned voffA[2], voffB[2];
#pragma unroll
    for (int i = 0; i < 2; ++i) { int R, C; stage_rc(tid * 16 + i * 8192, R, C); const int Rb = Epi::PERM ? ((R & ~31) + perm32(R & 31)) : R;
        voffA[i] = (unsigned)(R * K + C) * 2u; voffB[i] = (unsigned)(Rb * K + C) * 2u; }
    const size_t kstep = (size_t)(BK * 2);
    const size_t hstep = (size_t)HALF * K * 2;
    const size_t tstep = 2 * hstep;
    const unsigned ldsw = (unsigned)wid * 1024u;
    const int aoff = lds_byte(wr * 64 + fr, fq * 8), boff = lds_byte(wc * 32 + fr, fq * 8);
#define PG8_SA(b, h) (((b) * 2 + (h)) * HTB)
#define PG8_SB(b, h) ((4 + (b) * 2 + (h)) * HTB)
#define PG8_STAGE(bufoff, gbase, voff) do { _Pragma("unroll") for (int _i = 0; _i < 2; ++_i) \
        __builtin_amdgcn_global_load_lds((const unsigned*)((const char*)(gbase) + (voff)[_i]), (PG8_LAS unsigned*)(lds + (bufoff) + ldsw + _i * 8192), 16, 0, 0); } while (0)
#define PG8_LDA(dst, b, h) do { _Pragma("unroll") for (int m = 0; m < 4; ++m) _Pragma("unroll") for (int k = 0; k < 2; ++k) dst[m][k] = *(const PG8_LAS bf16x8*)(lds + PG8_SA(b, h) + aoff + m * 2048 + k * 1024); } while (0)
#define PG8_LDB(dst, b, h) do { _Pragma("unroll") for (int n = 0; n < 2; ++n) _Pragma("unroll") for (int k = 0; k < 2; ++k) dst[n][k] = *(const PG8_LAS bf16x8*)(lds + PG8_SB(b, h) + boff + n * 2048 + k * 1024); } while (0)
#define PG8_MMA(ai, bj, At, Bt) do { __builtin_amdgcn_s_setprio(1); _Pragma("unroll") for (int m = 0; m < 4; ++m) _Pragma("unroll") for (int n = 0; n < 2; ++n) _Pragma("unroll") for (int k = 0; k < 2; ++k) \
        acc[ai][bj][m][n] = __builtin_amdgcn_mfma_f32_16x16x32_bf16(Bt[n][k], At[m][k], acc[ai][bj][m][n], 0, 0, 0); __builtin_amdgcn_s_setprio(0); } while (0)
#define PG8_WAIT_V(n) asm volatile("s_waitcnt vmcnt(" #n ")" ::: "memory")
#define PG8_WAIT_L(n) asm volatile("s_waitcnt lgkmcnt(" #n ")" ::: "memory")
#define PG8_BAR __builtin_amdgcn_s_barrier()
#define PG8_SCHED __builtin_amdgcn_sched_barrier(0)
    Unit cur, nxt; int ui = 0;
    if (!S.next(0, cur)) return;
    f32x4 acc[2][2][4][2];
#pragma unroll
    for (int a = 0; a < 2; ++a)
#pragma unroll
        for (int b = 0; b < 2; ++b)
#pragma unroll
            for (int m = 0; m < 4; ++m)
#pragma unroll
                for (int n = 0; n < 2; ++n) acc[a][b][m][n] = (f32x4){0.f, 0.f, 0.f, 0.f};
    bf16x8 At[4][2], B0[2][2], B1[2][2];
    const char* cA = (const char*)g.A + (size_t)cur.pm * tstep; const char* cB = (const char*)g.Bt + (size_t)cur.pn * tstep;
    S.a_ready(cur);
    if constexpr (SP2) {
        PG8_STAGE(PG8_SB(0, 0), cB, voffB); PG8_STAGE(PG8_SB(0, 1), cB + hstep, voffB); PG8_STAGE(PG8_SA(0, 0), cA, voffA); PG8_STAGE(PG8_SA(0, 1), cA + hstep, voffA);
        if (wr == 1) PG8_BAR;
        PG8_WAIT_V(2); PG8_BAR;
        PG8_STAGE(PG8_SB(1, 0), cB + kstep, voffB); PG8_STAGE(PG8_SA(1, 0), cA + kstep, voffA); PG8_STAGE(PG8_SB(1, 1), cB + hstep + kstep, voffB);
        PG8_WAIT_V(6); PG8_BAR;
    } else {
        PG8_STAGE(PG8_SB(0, 0), cB, voffB); PG8_STAGE(PG8_SA(0, 0), cA, voffA); PG8_STAGE(PG8_SB(0, 1), cB + hstep, voffB); PG8_STAGE(PG8_SA(0, 1), cA + hstep, voffA);
        if (wr == 1) PG8_BAR;
        PG8_WAIT_V(4); PG8_BAR;
        PG8_STAGE(PG8_SB(1, 0), cB + kstep, voffB); PG8_STAGE(PG8_SA(1, 0), cA + kstep, voffA); PG8_STAGE(PG8_SB(1, 1), cB + hstep + kstep, voffB);
        PG8_WAIT_V(6); PG8_BAR;
    }
    for (;;) {
        const bool has_next = S.next(ui + 1, nxt);
        const char* nA = has_next ? (const char*)g.A + (size_t)nxt.pm * tstep : cA; const char* nB = has_next ? (const char*)g.Bt + (size_t)nxt.pn * tstep : cB;
        for (int t = 0; t < nt; t += 2) {
            const bool last = (t == nt - 2);
            const char* a1 = cA + (size_t)(t + 1) * kstep;
            const char* a2 = last ? nA : cA + (size_t)(t + 2) * kstep; const char* b2 = last ? nB : cB + (size_t)(t + 2) * kstep;
            const char* a3 = a2 + kstep; const char* b3 = b2 + kstep;
            if (last && has_next) S.a_ready(nxt);
            if constexpr (SP2) {
            PG8_LDB(B0, 0, 0); PG8_LDB(B1, 0, 1); PG8_SCHED; PG8_LDA(At, 0, 0); PG8_STAGE(PG8_SA(1, 1), a1 + hstep, voffA);
            PG8_WAIT_V(8); PG8_WAIT_L(0); PG8_BAR; PG8_MMA(0, 0, At, B0); PG8_MMA(0, 1, At, B1); PG8_BAR; PG8_SCHED;
            PG8_LDA(At, 0, 1); PG8_STAGE(PG8_SB(0, 0), b2, voffB); PG8_STAGE(PG8_SB(0, 1), b2 + hstep, voffB); PG8_STAGE(PG8_SA(0, 0), a2, voffA);
            PG8_WAIT_V(8); PG8_WAIT_L(0); PG8_BAR; PG8_MMA(1, 0, At, B0); PG8_MMA(1, 1, At, B1); PG8_BAR; PG8_SCHED;
            PG8_LDB(B0, 1, 0); PG8_LDB(B1, 1, 1); PG8_SCHED; PG8_LDA(At, 1, 0); PG8_STAGE(PG8_SA(0, 1), a2 + hstep, voffA);
            PG8_WAIT_V(8); PG8_WAIT_L(0); PG8_BAR; PG8_MMA(0, 0, At, B0); PG8_MMA(0, 1, At, B1); PG8_BAR; PG8_SCHED;
            PG8_LDA(At, 1, 1); PG8_STAGE(PG8_SB(1, 0), b3, voffB); PG8_STAGE(PG8_SB(1, 1), b3 + hstep, voffB); PG8_STAGE(PG8_SA(1, 0), a3, voffA);
            PG8_WAIT_V(8); PG8_WAIT_L(0); PG8_BAR; PG8_MMA(1, 0, At, B0); PG8_MMA(1, 1, At, B1); PG8_BAR; PG8_SCHED;
            } else {
            PG8_LDB(B0, 0, 0); PG8_SCHED; PG8_LDA(At, 0, 0); PG8_STAGE(PG8_SA(1, 1), a1 + hstep, voffA);
            PG8_WAIT_L(8); PG8_BAR; PG8_WAIT_L(0); PG8_MMA(0, 0, At, B0); PG8_BAR; PG8_SCHED;
            PG8_LDB(B1, 0, 1); PG8_STAGE(PG8_SB(0, 0), b2, voffB);
            PG8_BAR; PG8_WAIT_L(0); PG8_MMA(0, 1, At, B1); PG8_BAR;
            PG8_LDA(At, 0, 1); PG8_STAGE(PG8_SA(0, 0), a2, voffA);
            PG8_BAR; PG8_WAIT_L(0); PG8_MMA(1, 0, At, B0); PG8_BAR; PG8_SCHED;
            PG8_STAGE(PG8_SB(0, 1), b2 + hstep, voffB);
            PG8_WAIT_V(6); PG8_BAR; PG8_MMA(1, 1, At, B1); PG8_BAR;
            PG8_LDB(B0, 1, 0); PG8_SCHED; PG8_LDA(At, 1, 0); PG8_STAGE(PG8_SA(0, 1), a2 + hstep, voffA);
            PG8_WAIT_L(8); PG8_BAR; PG8_WAIT_L(0); PG8_MMA(0, 0, At, B0); PG8_BAR; PG8_SCHED;
            PG8_LDB(B1, 1, 1); PG8_STAGE(PG8_SB(1, 0), b3, voffB);
            PG8_BAR; PG8_WAIT_L(0); PG8_MMA(0, 1, At, B1); PG8_BAR;
            PG8_LDA(At, 1, 1); PG8_STAGE(PG8_SA(1, 0), a3, voffA);
            PG8_BAR; PG8_WAIT_L(0); PG8_MMA(1, 0, At, B0); PG8_BAR; PG8_SCHED;
            PG8_STAGE(PG8_SB(1, 1), b3 + hstep, voffB);
            PG8_WAIT_V(6); PG8_BAR; PG8_MMA(1, 1, At, B1); PG8_BAR;
            }
        }
        if constexpr (ALIGN_EPI) { if (wr == 0) PG8_BAR; }
        if constexpr (!Epi::AFTER_DRAIN) { E(acc, cur, wr, wc, fr, fq); S.done(cur); }
        if (!has_next) break;
#pragma unroll
        for (int a = 0; a < 2; ++a)
#pragma unroll
            for (int b = 0; b < 2; ++b)
#pragma unroll
                for (int m = 0; m < 4; ++m)
#pragma unroll
                    for (int n = 0; n < 2; ++n) acc[a][b][m][n] = (f32x4){0.f, 0.f, 0.f, 0.f};
        cur = nxt; cA = nA; cB = nB; ++ui;
        if constexpr (ALIGN_EPI) { if (wr == 1) PG8_BAR; }
    }
    PG8_WAIT_V(0);
    if constexpr (!ALIGN_EPI) { if (wr == 0) PG8_BAR; }
    PG8_BAR;
    if constexpr (Epi::AFTER_DRAIN) { E.fused(acc, cur, wr, wc, fr, fq, lds, wid, lane); S.done(cur); }
#undef PG8_SA
#undef PG8_SB
#undef PG8_STAGE
#undef PG8_LDA
#undef PG8_LDB
#undef PG8_MMA
#undef PG8_WAIT_V
#undef PG8_WAIT_L
#undef PG8_BAR
#undef PG8_SCHED
}
}

constexpr int NWAVES = 8;
#ifndef ONE_LAUNCH
#define ONE_LAUNCH 1
#endif
constexpr int BATCH = 2, SEQ = 8192, D = 1024, M = BATCH * SEQ, DEPTH = 2, MEMLEN = 256, FF = 4096;
constexpr int INW = 3200, INWP = 3328;
constexpr int ZVB = 0, ZUB = 256, ZQA = 512, ZKA = 896, ZVA = 1280, ZQC = 1664, ZKC = 2048, ZVC = 2432, ZGC = 2816;
constexpr int MIX_A = 0, MIX_B = 384, MIX_C = 640;
constexpr float EPS = 1e-6f;
constexpr int NPH_LAYER = 14, NPH = DEPTH * NPH_LAYER;

constexpr size_t MiB = 1u << 20;
constexpr size_t WS_CTL = 0, CTL_ZERO_BYTES = 1 * MiB;
constexpr size_t WS_WIN = 1 * MiB, WS_WOUT = 8 * MiB, WS_WQ = 10 * MiB, WS_WKV = 12 * MiB, WS_WO = 16 * MiB, WS_WUP = 18 * MiB, WS_WDN = 26 * MiB;
constexpr size_t WS_COS = 34 * MiB, WS_SIN = 36 * MiB;
constexpr size_t WS_MKV = 38 * MiB;
constexpr size_t WS_MEMN = 40 * MiB;
constexpr size_t WS_KV = 44 * MiB;
constexpr size_t WS_XN = 56 * MiB;
constexpr size_t WS_MIX = 88 * MiB;
constexpr size_t WS_Z = 120 * MiB;
constexpr size_t WS_Y = 120 * MiB, WS_Q = 152 * MiB, WS_H = 120 * MiB;
constexpr size_t WS_OBR01 = 56 * MiB, WS_LSE = 80 * MiB, WS_OBR2 = 224 * MiB;
constexpr size_t WS_END = 248 * MiB;
constexpr int CW_TMO = 0, CW_CODE = 1, CW_BAR = 4096;

constexpr int RING_OFF = 0, RING_BYTES = 131072;
constexpr int LDSCTL_OFF = 139264, MISC_OFF = LDSCTL_OFF + 320;
constexpr int LDS_BYTES = 147456;
#define GAS __attribute__((address_space(1)))
#define LAS __attribute__((address_space(3)))
typedef unsigned short bf16;
typedef unsigned v4u __attribute__((ext_vector_type(4)));
typedef float f32x4 __attribute__((ext_vector_type(4)));
typedef short bf16x8 __attribute__((ext_vector_type(8)));
typedef GAS unsigned gu32;
typedef GAS unsigned long long gu64;
#define RLX_AGENT __ATOMIC_RELAXED, __HIP_MEMORY_SCOPE_AGENT
#define LDS_WAIT() asm volatile("s_waitcnt lgkmcnt(0)" ::: "memory")
#define VM_WAIT() asm volatile("s_waitcnt vmcnt(0)" ::: "memory")
__device__ __forceinline__ unsigned long long rt() { return __builtin_amdgcn_s_memrealtime(); }
__device__ __forceinline__ unsigned f2bf(float f) { unsigned u = __builtin_bit_cast(unsigned, f); return (u + 0x7fffu + ((u >> 16) & 1u)) >> 16; }
__device__ __forceinline__ unsigned pk2(float lo, float hi) { return f2bf(lo) | (f2bf(hi) << 16); }
#define XB_TMO      128
#define XB_XCNT(j)  (256  + 64 * (j))
#define XB_XSUB(j)  (1280 + 64 * (j))
#define XB_XGEN(j)  (2304 + 64 * (j))
#define XB_TOP      3328
#define XB_TOPGEN   3392
#define XCD_BAR_WORDS 3456
#define XB_SPIN_CAP (1u << 18)

__device__ __forceinline__ unsigned xb_ld(unsigned* p)              { return __hip_atomic_load(p, __ATOMIC_RELAXED, __HIP_MEMORY_SCOPE_AGENT); }
__device__ __forceinline__ unsigned xb_add(unsigned* p, unsigned v) { return __hip_atomic_fetch_add(p, v, __ATOMIC_RELAXED, __HIP_MEMORY_SCOPE_AGENT); }
__device__ __forceinline__ unsigned xb_xcc_id() { return (unsigned)__builtin_amdgcn_s_getreg((3 << 11) | 20) & 0xFu; }
#define XB_SPIN(cond, bar) do { unsigned _sp = 0; while (cond) { __builtin_amdgcn_s_sleep(1); \
    if ((++_sp & 255u) == 0u) { if (xb_ld(&(bar)[XB_TMO])) break; if (_sp > XB_SPIN_CAP) { atomicAdd(&(bar)[XB_TMO], 1u); break; } } } } while (0)

struct XcdBarrier {
    unsigned* bar; unsigned x;
    volatile LAS unsigned* st;
};

__device__ __forceinline__ XcdBarrier xcd_barrier_post(unsigned* bar, volatile LAS unsigned* st) {
    XcdBarrier b; b.bar = bar; b.x = xb_xcc_id(); b.st = st;
    if (threadIdx.x == 0) (void)xb_add(&bar[XB_XCNT(b.x)], 1u);
    return b;
}
__device__ __forceinline__ void xcd_barrier_complete(unsigned* bar, unsigned x, unsigned& nloc, unsigned& nx) {
    const unsigned G = gridDim.x * gridDim.y * gridDim.z;
    unsigned sum, cnt, mine, sp = 0u;
    for (;;) {
        sum = 0u; cnt = 0u; mine = 0u;
#pragma unroll
        for (unsigned j = 0; j < 16; ++j) { const unsigned c = xb_ld(&bar[XB_XCNT(j)]); sum += c; cnt += (c > 0u) ? 1u : 0u; mine = (j == x) ? c : mine; }
        if (sum == G) break;
        __builtin_amdgcn_s_sleep(1);
        if ((++sp & 255u) == 0u) { if (xb_ld(&bar[XB_TMO])) break; if (sp > XB_SPIN_CAP) { atomicAdd(&bar[XB_TMO], 1u); break; } }
    }
    nloc = mine > 0u ? mine : 1u; nx = cnt > 0u ? cnt : 1u;
}

__device__ __forceinline__ void xcd_barrier(const XcdBarrier& b) {
    asm volatile("s_waitcnt vmcnt(0)" ::: "memory");
    __syncthreads();
    if (threadIdx.x == 0) {
        unsigned* bar = b.bar;
        __builtin_amdgcn_s_waitcnt(0);
        unsigned nloc = b.st[0], nx = b.st[1];
        if (nloc == 0u) { xcd_barrier_complete(bar, b.x, nloc, nx); b.st[0] = nloc; b.st[1] = nx; }
        const unsigned old = xb_add(&bar[XB_XSUB(b.x)], 1u);
        const unsigned gen = old / nloc;
        if (old + 1u == (gen + 1u) * nloc) {
            __builtin_amdgcn_fence(__ATOMIC_RELEASE, "agent");
            asm volatile("s_waitcnt vmcnt(0)" ::: "memory");
            const unsigned og = xb_add(&bar[XB_TOP], 1u);
            const unsigned tg = og / nx;
            if (og + 1u == (tg + 1u) * nx) xb_add(&bar[XB_TOPGEN], 1u);
            else XB_SPIN(xb_ld(&bar[XB_TOPGEN]) == tg, bar);
            __builtin_amdgcn_fence(__ATOMIC_ACQUIRE, "agent");
            xb_add(&bar[XB_XGEN(b.x)], 1u);
            asm volatile("s_waitcnt vmcnt(0)" ::: "memory");
        } else {
            XB_SPIN(xb_ld(&bar[XB_XGEN(b.x)]) == gen, bar);
            __builtin_amdgcn_fence(__ATOMIC_ACQUIRE, "agent");
            asm volatile("s_waitcnt vmcnt(0)" ::: "memory");
        }
    }
    __syncthreads();
}
template <int MASK> __device__ __forceinline__ float sxor(float v) { return __int_as_float(__builtin_amdgcn_ds_swizzle(__float_as_int(v), (MASK << 10) | 0x1f)); }
__device__ __forceinline__ float half_sum(float v) { auto rr = __builtin_amdgcn_permlane32_swap(__float_as_uint(v), __float_as_uint(v), false, false); return __uint_as_float(rr[0]) + __uint_as_float(rr[1]); }
__device__ __forceinline__ float half_max(float v) { auto rr = __builtin_amdgcn_permlane32_swap(__float_as_uint(v), __float_as_uint(v), false, false); return fmaxf(__uint_as_float(rr[0]), __uint_as_float(rr[1])); }
__device__ __forceinline__ float wave_sum(float v) {
    v += sxor<1>(v); v += sxor<2>(v); v += sxor<4>(v); v += sxor<8>(v); v += sxor<16>(v); return half_sum(v);
}

__device__ __forceinline__ float bf_lo(unsigned w) { return __uint_as_float(w << 16); }
__device__ __forceinline__ float bf_hi(unsigned w) { return __uint_as_float(w & 0xffff0000u); }
__device__ __forceinline__ float bf1(bf16 h) { return __uint_as_float((unsigned)h << 16); }
__device__ __forceinline__ float gelu_tanh(float x) {
    const float u = 0.7978845608028654f * (x + 0.044715f * x * x * x);
    const float e = __expf(2.f * u);
    const float t = 1.f - 2.f / (e + 1.f);
    return 0.5f * x * (1.f + t);
}
__device__ __forceinline__ float dot8(const v4u a, const float* q) {
    return q[0] * bf_lo(a.x) + q[1] * bf_hi(a.x) + q[2] * bf_lo(a.y) + q[3] * bf_hi(a.y) + q[4] * bf_lo(a.z) + q[5] * bf_hi(a.z) + q[6] * bf_lo(a.w) + q[7] * bf_hi(a.w);
}
__device__ __forceinline__ void unpack8(const v4u a, float* f) {
    f[0] = bf_lo(a.x); f[1] = bf_hi(a.x); f[2] = bf_lo(a.y); f[3] = bf_hi(a.y); f[4] = bf_lo(a.z); f[5] = bf_hi(a.z); f[6] = bf_lo(a.w); f[7] = bf_hi(a.w);
}
__device__ __forceinline__ int win_row(int n0) { return n0 < 1152 ? n0 + 512 : (n0 < 1408 ? n0 - 896 : (n0 < 1664 ? n0 - 1408 : n0)); }

__device__ __forceinline__ void tr_item(const float* W, int K, int N, bf16* WT, int mode, LAS float* scr, int item, int lane) {
    const int nblk = N / 32, kb = item / nblk, nb = item % nblk, k0 = 64 * kb, n0 = 32 * nb;
    const int rb = mode ? win_row(n0) : n0;
#pragma unroll 8
    for (int i = 0; i < 32; ++i) { const int kk = 2 * i + (lane >> 5); scr[kk * 33 + (lane & 31)] = W[(size_t)(k0 + kk) * N + n0 + (lane & 31)]; }
    LDS_WAIT(); asm volatile("" ::: "memory");
    const int c = lane & 7;
#pragma unroll
    for (int j = 0; j < 4; ++j) { const int n = (lane >> 3) + 8 * j; const LAS float* s = scr + (8 * c) * 33 + n;
        v4u o; o.x = pk2(s[0 * 33], s[1 * 33]); o.y = pk2(s[2 * 33], s[3 * 33]); o.z = pk2(s[4 * 33], s[5 * 33]); o.w = pk2(s[6 * 33], s[7 * 33]);
        *(GAS v4u*)(WT + (size_t)(rb + n) * K + k0 + 8 * c) = o; }
    LDS_WAIT(); asm volatile("" ::: "memory");
}
__device__ __forceinline__ void rms_row_to_bf16(const float* xrow, const float* g, bf16* orow, int lane) {
    const GAS f32x4* xr = (const GAS f32x4*)xrow + lane; const GAS f32x4* gr = (const GAS f32x4*)g + lane;
    f32x4 v[4]; float s = 0.f;
#pragma unroll
    for (int j = 0; j < 4; ++j) { v[j] = xr[64 * j]; s += (v[j].x * v[j].x + v[j].y * v[j].y) + (v[j].z * v[j].z + v[j].w * v[j].w); }
    const float r = 1.f / sqrtf(wave_sum(s) * (1.f / D) + EPS);
    GAS unsigned long long* o8 = (GAS unsigned long long*)orow + lane;
#pragma unroll
    for (int j = 0; j < 4; ++j) { const f32x4 gg = gr[64 * j]; o8[64 * j] = (unsigned long long)pk2(v[j].x * r * gg.x, v[j].y * r * gg.y) | ((unsigned long long)pk2(v[j].z * r * gg.z, v[j].w * r * gg.w) << 32); }
}
__device__ __forceinline__ void res_row(const float* xin, const bf16* y, const float* gpost, const float* gpre, float* xout, bf16* xn, int lane) {
    const GAS unsigned long long* yr = (const GAS unsigned long long*)y + lane;
    f32x4 yv[4]; float s = 0.f;
#pragma unroll
    for (int j = 0; j < 4; ++j) { const unsigned long long w = yr[64 * j]; const unsigned lo = (unsigned)w, hi = (unsigned)(w >> 32);
        yv[j] = (f32x4){bf_lo(lo), bf_hi(lo), bf_lo(hi), bf_hi(hi)}; s += (yv[j].x * yv[j].x + yv[j].y * yv[j].y) + (yv[j].z * yv[j].z + yv[j].w * yv[j].w); }
    const float r = 1.f / sqrtf(wave_sum(s) * (1.f / D) + EPS);
    f32x4 xv[4]; float s2 = 0.f;
#pragma unroll
    for (int j = 0; j < 4; ++j) { const f32x4 gg = ((const GAS f32x4*)gpost + lane)[64 * j]; const f32x4 xi = ((const GAS f32x4*)xin + lane)[64 * j];
        xv[j] = xi + yv[j] * r * gg; ((GAS f32x4*)xout + lane)[64 * j] = xv[j];
        s2 += (xv[j].x * xv[j].x + xv[j].y * xv[j].y) + (xv[j].z * xv[j].z + xv[j].w * xv[j].w); }
    if (gpre) {
        const float r2 = 1.f / sqrtf(wave_sum(s2) * (1.f / D) + EPS);
        GAS unsigned long long* o8 = (GAS unsigned long long*)xn + lane;
#pragma unroll
        for (int j = 0; j < 4; ++j) { const f32x4 gg = ((const GAS f32x4*)gpre + lane)[64 * j];
            o8[64 * j] = (unsigned long long)pk2(xv[j].x * r2 * gg.x, xv[j].y * r2 * gg.y) | ((unsigned long long)pk2(xv[j].z * r2 * gg.z, xv[j].w * r2 * gg.w) << 32); }
    }
}


typedef float f32x16 __attribute__((ext_vector_type(16)));
typedef short s16x4 __attribute__((ext_vector_type(4)));
typedef short v4i16_t __attribute__((ext_vector_type(4)));
typedef float f32x2_t __attribute__((ext_vector_type(2))); typedef __bf16 bf16x2_t __attribute__((ext_vector_type(2)));
__device__ __forceinline__ unsigned cvtpk(float lo, float hi) { f32x2_t v = {lo, hi}; bf16x2_t b = __builtin_convertvector(v, bf16x2_t); return __builtin_bit_cast(unsigned, b); }
__device__ __forceinline__ s16x4 tr16(LAS unsigned char* p) { return __builtin_bit_cast(s16x4, __builtin_amdgcn_ds_read_tr16_b64_v4i16((LAS v4i16_t*)p)); }
__device__ __forceinline__ int crow(int r, int hi) { return (r & 3) + 8 * (r >> 2) + 4 * hi; }
#define MFMA32(a, b, c) __builtin_amdgcn_mfma_f32_32x32x16_bf16((a), (b), (c), 0, 0, 0)
__device__ __forceinline__ bf16x8 mk8(s16x4 lo, s16x4 hi) { return (bf16x8){lo[0], lo[1], lo[2], lo[3], hi[0], hi[1], hi[2], hi[3]}; }
__device__ __forceinline__ bf16x8 mk8u(unsigned a, unsigned b, unsigned c, unsigned d) { const v4u w = {a, b, c, d}; return __builtin_bit_cast(bf16x8, w); }

__device__ __forceinline__ void xattn_unit(const bf16* Q, const bf16* MKV, bf16* O, LAS unsigned char* lds, int unit, int tid) {
    const int h = unit & 3, tile = (unit >> 2) & 31, b = unit >> 7;
    const int lane = tid & 63, w = __builtin_amdgcn_readfirstlane(tid >> 6), r = lane & 31, hh = lane >> 5;
    const size_t row0 = (size_t)b * SEQ + tile * 256;
    bf16x8 qf[16];
    { const bf16* qp = Q + (row0 + 32 * w + r) * D + h * 256 + 8 * hh;
#pragma unroll
      for (int s = 0; s < 16; ++s) qf[s] = *(const GAS bf16x8*)(qp + 16 * s); }
    const bf16* kbase = MKV + (size_t)(b * 256) * 2048 + h * 256;
#pragma unroll 4
    for (int i = 0; i < 16; ++i) { const int idx = tid + 512 * i, row = idx >> 5, c = idx & 31;
        const v4u v = *(const GAS v4u*)(kbase + (size_t)row * 2048 + c * 8);
        *(LAS v4u*)(lds + row * 528 + (c << 4)) = v; }
    __syncthreads();
    f32x16 acc[8];
    const LAS unsigned char* kb = lds + r * 528 + hh * 16;
#pragma unroll
    for (int t = 0; t < 8; ++t) {
#pragma unroll
        for (int e = 0; e < 16; ++e) acc[t][e] = 0.f;
#pragma unroll
        for (int s = 0; s < 16; ++s) {
            const bf16x8 a = *(const LAS bf16x8*)(kb + t * (32 * 528) + s * 32);
            acc[t] = MFMA32(a, qf[s], acc[t]);
        }
    }
    float mx = -INFINITY;
#pragma unroll
    for (int t = 0; t < 8; ++t)
#pragma unroll
        for (int e = 0; e < 16; ++e) mx = fmaxf(mx, acc[t][e]);
    mx = half_max(mx);
    constexpr float C2 = 0.0625f * 1.4426950408889634f;
    const float mc = mx * C2;
    float l = 0.f;
    unsigned pk[8][8];
#pragma unroll
    for (int t = 0; t < 8; ++t) {
#pragma unroll
        for (int e = 0; e < 16; ++e) { const float p = __builtin_amdgcn_exp2f(acc[t][e] * C2 - mc); acc[t][e] = p; l += p; }
#pragma unroll
        for (int e = 0; e < 8; ++e) pk[t][e] = cvtpk(acc[t][2 * e], acc[t][2 * e + 1]);
    }
    l = half_sum(l);
    const float il = 1.f / l;
    __syncthreads();
#pragma unroll 4
    for (int i = 0; i < 16; ++i) { const int idx = tid + 512 * i, row = idx >> 5, c = idx & 31;
        const v4u v = *(const GAS v4u*)(kbase + 1024 + (size_t)row * 2048 + c * 8);
        *(LAS v4u*)(lds + row * 512 + ((c ^ ((row & 3) << 2)) << 4)) = v; }
    __syncthreads();
    f32x16 oacc[8];
#pragma unroll
    for (int u = 0; u < 8; ++u)
#pragma unroll
        for (int e = 0; e < 16; ++e) oacc[u][e] = 0.f;
    const int g1 = (lane >> 4) & 1, q4 = (lane & 15) >> 2, p4 = lane & 3;
    LAS unsigned char* vb = lds + (4 * hh + q4) * 512 + ((2 * g1 + (p4 >> 1)) << 4) + 8 * (p4 & 1);
#pragma unroll
    for (int t = 0; t < 8; ++t) {
#pragma unroll
        for (int s2 = 0; s2 < 2; ++s2) {
            const bf16x8 bfrag = mk8u(pk[t][4 * s2], pk[t][4 * s2 + 1], pk[t][4 * s2 + 2], pk[t][4 * s2 + 3]);
#pragma unroll
            for (int u = 0; u < 8; ++u) {
                LAS unsigned char* p = vb + (32 * t + 16 * s2) * 512 + (((u ^ q4) << 2) << 4);
                const s16x4 lo = tr16(p), hi = tr16(p + 8 * 512);
                oacc[u] = MFMA32(mk8(lo, hi), bfrag, oacc[u]);
            }
        }
    }
    __syncthreads();
    { int lane2 = lane; asm volatile("" : "+v"(lane2));
      const int r = lane2 & 31, hh = lane2 >> 5;
      LAS unsigned char* orow = lds + (32 * w + r) * 512;
#pragma unroll
      for (int u = 0; u < 8; ++u)
#pragma unroll
          for (int c4 = 0; c4 < 4; ++c4) {
              const unsigned lo = cvtpk(oacc[u][4 * c4] * il, oacc[u][4 * c4 + 1] * il), hi = cvtpk(oacc[u][4 * c4 + 2] * il, oacc[u][4 * c4 + 3] * il);
              *(LAS unsigned long long*)(orow + (((4 * u + c4) ^ r) << 4) + 8 * hh) = (unsigned long long)lo | ((unsigned long long)hi << 32); }
#pragma unroll
      for (int i = 0; i < 16; ++i) { const int rl = 2 * i + hh, cl = r;
          const v4u v = *(const LAS v4u*)(lds + (32 * w + rl) * 512 + ((cl ^ rl) << 4));
          *(GAS v4u*)(O + (row0 + 32 * w + rl) * D + h * 256 + cl * 8) = v; } }
    __syncthreads();
}

constexpr int DIL_KP = 144, DIL_VOFF = 384 * DIL_KP, DIL_UNITS = 2 * 6 * 3 * 32;
__device__ __forceinline__ void dil_unit(const bf16* Z, bf16* OBR01, bf16* OBR2, float* LSE, LAS unsigned char* lds, int unit, int tid) {
    const int x = unit & 31, bhb = unit >> 5, br = bhb % 3, bh = bhb / 3, h = bh % 6, b = bh / 6;
    const int d = br == 0 ? 1 : (br == 1 ? 4 : 16);
    const int res = br == 0 ? 0 : (br == 1 ? (x >> 3) : (x >> 1)), np = br == 0 ? x : (br == 1 ? (x & 7) : (x & 1));
    const int lane = tid & 63, w = __builtin_amdgcn_readfirstlane(tid >> 6), i = lane & 31, hh = lane >> 5;
    const size_t brow = (size_t)b * SEQ;
    const int qpos = (256 * np + 32 * w + i) * d + res;
    bf16x8 qf[4];
    { const bf16* qp = Z + (brow + qpos) * INWP + ZQA + h * 64 + 8 * hh;
#pragma unroll
      for (int s = 0; s < 4; ++s) qf[s] = *(const GAS bf16x8*)(qp + 16 * s); }
#pragma unroll
    for (int it = 0; it < 6; ++it) { const int idx = tid + 512 * it, row = idx >> 3, c = idx & 7;
        const int sub = 256 * np - 128 + row; v4u kv = {0u, 0u, 0u, 0u}, vv = {0u, 0u, 0u, 0u};
        if (sub >= 0) { const bf16* src = Z + (brow + (size_t)sub * d + res) * INWP + h * 64 + c * 8; kv = *(const GAS v4u*)(src + ZKA); vv = *(const GAS v4u*)(src + ZVA); }
        *(LAS v4u*)(lds + row * DIL_KP + (c << 4)) = kv;
        *(LAS v4u*)(lds + DIL_VOFF + row * 128 + ((c ^ (((row >> 1) & 1) << 2)) << 4)) = vv; }
    __syncthreads();
    f32x16 acc[5];
    { const LAS unsigned char* kb = lds + (32 * w + i) * DIL_KP + hh * 16;
#pragma unroll
      for (int t = 0; t < 5; ++t) {
#pragma unroll
          for (int e = 0; e < 16; ++e) acc[t][e] = 0.f;
#pragma unroll
          for (int s = 0; s < 4; ++s) acc[t] = MFMA32(*(const LAS bf16x8*)(kb + t * (32 * DIL_KP) + s * 32), qf[s], acc[t]);
      } }
    constexpr float NEG = -1e30f;
#pragma unroll
    for (int e = 0; e < 16; ++e) { const int kr = crow(e, hh); if (kr < i) acc[0][e] = NEG; if (kr > i) acc[4][e] = NEG; }
    if (np == 0) {
#pragma unroll
        for (int t = 0; t < 4; ++t) if (w + t < 4) {
#pragma unroll
            for (int e = 0; e < 16; ++e) acc[t][e] = NEG; }
    }
    float mx = NEG;
#pragma unroll
    for (int t = 0; t < 5; ++t)
#pragma unroll
        for (int e = 0; e < 16; ++e) mx = fmaxf(mx, acc[t][e]);
    mx = half_max(mx);
    constexpr float C2 = 0.125f * 1.4426950408889634f;
    const float mc = mx * C2;
    float l = 0.f;
    unsigned pk[5][8];
#pragma unroll
    for (int t = 0; t < 5; ++t) {
#pragma unroll
        for (int e = 0; e < 16; ++e) { const float p = __builtin_amdgcn_exp2f(acc[t][e] * C2 - mc); acc[t][e] = p; l += p; }
#pragma unroll
        for (int e = 0; e < 8; ++e) pk[t][e] = cvtpk(acc[t][2 * e], acc[t][2 * e + 1]);
    }
    l = half_sum(l);
    f32x16 oacc[2];
#pragma unroll
    for (int u = 0; u < 2; ++u)
#pragma unroll
        for (int e = 0; e < 16; ++e) oacc[u][e] = 0.f;
    { const int g1 = (lane >> 4) & 1, q4 = (lane & 15) >> 2, p4 = lane & 3, sw = (q4 >> 1) & 1;
      LAS unsigned char* vb = lds + DIL_VOFF + (32 * w + 4 * hh + q4) * 128 + ((2 * g1 + (p4 >> 1)) << 4) + 8 * (p4 & 1);
#pragma unroll
      for (int t = 0; t < 5; ++t)
#pragma unroll
          for (int s2 = 0; s2 < 2; ++s2) {
              const bf16x8 bfrag = mk8u(pk[t][4 * s2], pk[t][4 * s2 + 1], pk[t][4 * s2 + 2], pk[t][4 * s2 + 3]);
#pragma unroll
              for (int u = 0; u < 2; ++u) {
                  LAS unsigned char* p = vb + (32 * t + 16 * s2) * 128 + (((u ^ sw) << 2) << 4);
                  const s16x4 lo = tr16(p), hi = tr16(p + 8 * 128);
                  oacc[u] = MFMA32(mk8(lo, hi), bfrag, oacc[u]);
              }
          } }
    { int lane2 = lane; asm volatile("" : "+v"(lane2));
      const int i2 = lane2 & 31, hh2 = lane2 >> 5;
      const float il = 1.f / l;
      const size_t tok = brow + (size_t)(256 * np + 32 * w + i2) * d + res;
      bf16* ob = (br < 2 ? OBR01 + (size_t)br * M * 384 : OBR2) + tok * 384 + h * 64 + 4 * hh2;
#pragma unroll
      for (int u = 0; u < 2; ++u)
#pragma unroll
          for (int c4 = 0; c4 < 4; ++c4) {
              const unsigned lo = cvtpk(oacc[u][4 * c4] * il, oacc[u][4 * c4 + 1] * il), hi = cvtpk(oacc[u][4 * c4 + 2] * il, oacc[u][4 * c4 + 3] * il);
              *(GAS unsigned long long*)(ob + 32 * u + 8 * c4) = (unsigned long long)lo | ((unsigned long long)hi << 32); }
      if (hh2 == 0) LSE[((size_t)br * M + tok) * 6 + h] = mx * 0.125f + __logf(l); }
    __syncthreads();
}
__device__ __forceinline__ void dil_combine(const bf16* OBR01, const bf16* OBR2, const float* LSE, bf16* MIX, int gt, int NGT) {
    for (int idx = gt; idx < M * 48; idx += NGT) {
        const int c = idx % 48, tok = idx / 48, h = c >> 3;
        const float l0 = LSE[((size_t)0 * M + tok) * 6 + h], l1 = LSE[((size_t)1 * M + tok) * 6 + h], l2 = LSE[((size_t)2 * M + tok) * 6 + h];
        const float mx = fmaxf(l0, fmaxf(l1, l2));
        float w0 = __expf(l0 - mx), w1 = __expf(l1 - mx), w2 = __expf(l2 - mx); const float iw = 1.f / (w0 + w1 + w2); w0 *= iw; w1 *= iw; w2 *= iw;
        float a[8], bb[8], cc[8];
        unpack8(*(const GAS v4u*)(OBR01 + (size_t)tok * 384 + c * 8), a);
        unpack8(*(const GAS v4u*)(OBR01 + ((size_t)M + tok) * 384 + c * 8), bb);
        unpack8(*(const GAS v4u*)(OBR2 + (size_t)tok * 384 + c * 8), cc);
        v4u o;
        o.x = pk2(w0 * a[0] + w1 * bb[0] + w2 * cc[0], w0 * a[1] + w1 * bb[1] + w2 * cc[1]);
        o.y = pk2(w0 * a[2] + w1 * bb[2] + w2 * cc[2], w0 * a[3] + w1 * bb[3] + w2 * cc[3]);
        o.z = pk2(w0 * a[4] + w1 * bb[4] + w2 * cc[4], w0 * a[5] + w1 * bb[5] + w2 * cc[5]);
        o.w = pk2(w0 * a[6] + w1 * bb[6] + w2 * cc[6], w0 * a[7] + w1 * bb[7] + w2 * cc[7]);
        *(GAS v4u*)(MIX + (size_t)tok * D + MIX_A + c * 8) = o;
    }
}

constexpr int RET_LDS_UNIT = 34816;
__device__ __forceinline__ float ret_lg2(int h) { return log1pf(-exp2f(-5.f - (float)h)) * 1.4426950408889634f; }
__device__ __forceinline__ void ret_stage(const bf16* Z, const float* COS, const float* SIN, LAS unsigned char* kl, LAS unsigned char* vl, size_t row0, int h, float lg2, int kmode, int tl) {
#pragma unroll
    for (int it = 0; it < 2; ++it) { const int idx = tl + 256 * it, j = idx >> 2, c = idx & 3; const size_t row = row0 + j;
        const bf16* kp = Z + row * INWP + ZKC + h * 64 + 8 * c;
        const v4u r1 = *(const GAS v4u*)kp, r2 = *(const GAS v4u*)(kp + 32);
        const f32x4 ca = *(const GAS f32x4*)(COS + row * 32 + 8 * c), cb = *(const GAS f32x4*)(COS + row * 32 + 8 * c + 4);
        const f32x4 sa = *(const GAS f32x4*)(SIN + row * 32 + 8 * c), sb = *(const GAS f32x4*)(SIN + row * 32 + 8 * c + 4);
        float t1[8], t2[8]; unpack8(r1, t1); unpack8(r2, t2);
        const float cs[8] = {ca[0], ca[1], ca[2], ca[3], cb[0], cb[1], cb[2], cb[3]}, sn[8] = {sa[0], sa[1], sa[2], sa[3], sb[0], sb[1], sb[2], sb[3]};
        const float sc = 0.125f * __builtin_amdgcn_exp2f(-(float)j * lg2);
        float o1[8], o2[8];
#pragma unroll
        for (int e = 0; e < 8; ++e) { o1[e] = (t1[e] * cs[e] - t2[e] * sn[e]) * sc; o2[e] = (t2[e] * cs[e] + t1[e] * sn[e]) * sc; }
        const v4u w1 = {cvtpk(o1[0], o1[1]), cvtpk(o1[2], o1[3]), cvtpk(o1[4], o1[5]), cvtpk(o1[6], o1[7])}, w2 = {cvtpk(o2[0], o2[1]), cvtpk(o2[2], o2[3]), cvtpk(o2[4], o2[5]), cvtpk(o2[6], o2[7])};
        if (kmode == 0) { const int sw = ((j >> 1) & 1) << 2; *(LAS v4u*)(kl + j * 128 + ((c ^ sw) << 4)) = w1; *(LAS v4u*)(kl + j * 128 + (((c + 4) ^ sw) << 4)) = w2; }
        else { *(LAS v4u*)(kl + j * 144 + (c << 4)) = w1; *(LAS v4u*)(kl + j * 144 + ((c + 4) << 4)) = w2; } }
#pragma unroll
    for (int it = 0; it < 4; ++it) { const int idx = tl + 256 * it, j = idx >> 3, c = idx & 7;
        const v4u v = *(const GAS v4u*)(Z + (row0 + j) * INWP + ZVC + h * 64 + 8 * c);
        *(LAS v4u*)(vl + j * 128 + ((c ^ (((j >> 1) & 1) << 2)) << 4)) = v; }
}
__device__ __forceinline__ bf16x8 tr_frag(LAS unsigned char* img, int rbase, int ct, int lane) {
    const int hh = lane >> 5, g1 = (lane >> 4) & 1, q4 = (lane & 15) >> 2, p4 = lane & 3, sw = (q4 >> 1) & 1;
    LAS unsigned char* p = img + (rbase + 4 * hh + q4) * 128 + ((((ct ^ sw) << 2) + 2 * g1 + (p4 >> 1)) << 4) + 8 * (p4 & 1);
    return mk8(tr16(p), tr16(p + 8 * 128));
}
__device__ __forceinline__ void ret1_pair(const bf16* Z, const float* COS, const float* SIN, float* ST, LAS unsigned char* lds, int pair, int tid) {
    const int half = __builtin_amdgcn_readfirstlane(tid >> 8), tl = tid & 255, lane = tid & 63, w4 = __builtin_amdgcn_readfirstlane((tid >> 6) & 3);
    const int unit = 2 * pair + half, h = unit % 6, bn = unit / 6, n = bn & 63, b = bn >> 6; const size_t row0 = (size_t)b * SEQ + n * 128;
    LAS unsigned char* kl = lds + half * RET_LDS_UNIT; LAS unsigned char* vl = kl + 18432;
    const float lg2 = ret_lg2(h);
    ret_stage(Z, COS, SIN, kl, vl, row0, h, lg2, 0, tl);
    __syncthreads();
    const int a = w4 >> 1, c = w4 & 1;
    f32x16 acc;
#pragma unroll
    for (int e = 0; e < 16; ++e) acc[e] = 0.f;
#pragma unroll
    for (int s = 0; s < 8; ++s) acc = MFMA32(tr_frag(vl, 16 * s, a, lane), tr_frag(kl, 16 * s, c, lane), acc);
    const float g127 = __builtin_amdgcn_exp2f(127.f * lg2);
    float* out = ST + ((size_t)(b * 6 + h) * 64 + n) * 4096 + (size_t)(32 * a + 4 * (lane >> 5)) * 64 + 32 * c + (lane & 31);
#pragma unroll
    for (int e = 0; e < 16; ++e) out[((e & 3) + 8 * (e >> 2)) * 64] = acc[e] * g127;
    __syncthreads();
}
__device__ __forceinline__ void ret2_pair(const bf16* Z, const float* COS, const float* SIN, const float* ST, bf16* MIX, LAS unsigned char* lds, int pair, int tid) {
    const int half = __builtin_amdgcn_readfirstlane(tid >> 8), tl = tid & 255, lane = tid & 63, ti = __builtin_amdgcn_readfirstlane((tid >> 6) & 3);
    const int unit = 2 * pair + half, h = unit % 6, bn = unit / 6, n = bn & 63, b = bn >> 6; const size_t row0 = (size_t)b * SEQ + n * 128;
    LAS unsigned char* kl = lds + half * RET_LDS_UNIT; LAS unsigned char* vl = kl + 18432;
    const float lg2 = ret_lg2(h);
    const int i = lane & 31, hh = lane >> 5; const size_t row = row0 + 32 * ti + i;
    bf16x8 qf[4];
    { const bf16* qp = Z + row * INWP + ZQC + h * 64 + 8 * hh;
      float raw[4][8];
#pragma unroll
      for (int s = 0; s < 4; ++s) unpack8(*(const GAS v4u*)(qp + 16 * s), raw[s]);
      const float sc = __builtin_amdgcn_exp2f((float)(32 * ti + i) * lg2);
#pragma unroll
      for (int s = 0; s < 2; ++s) {
          const f32x4 ca = *(const GAS f32x4*)(COS + row * 32 + 16 * s + 8 * hh), cb = *(const GAS f32x4*)(COS + row * 32 + 16 * s + 8 * hh + 4);
          const f32x4 sa = *(const GAS f32x4*)(SIN + row * 32 + 16 * s + 8 * hh), sb = *(const GAS f32x4*)(SIN + row * 32 + 16 * s + 8 * hh + 4);
          const float cs[8] = {ca[0], ca[1], ca[2], ca[3], cb[0], cb[1], cb[2], cb[3]}, sn[8] = {sa[0], sa[1], sa[2], sa[3], sb[0], sb[1], sb[2], sb[3]};
          float o1[8], o2[8];
#pragma unroll
          for (int e = 0; e < 8; ++e) { o1[e] = (raw[s][e] * cs[e] - raw[s + 2][e] * sn[e]) * sc; o2[e] = (raw[s + 2][e] * cs[e] + raw[s][e] * sn[e]) * sc; }
          qf[s] = mk8u(cvtpk(o1[0], o1[1]), cvtpk(o1[2], o1[3]), cvtpk(o1[4], o1[5]), cvtpk(o1[6], o1[7]));
          qf[s + 2] = mk8u(cvtpk(o2[0], o2[1]), cvtpk(o2[2], o2[3]), cvtpk(o2[4], o2[5]), cvtpk(o2[6], o2[7]));
      } }
    ret_stage(Z, COS, SIN, kl, vl, row0, h, lg2, 1, tl);
    __syncthreads();
    unsigned pk[4][8];
#pragma unroll
    for (int tj = 0; tj < 4; ++tj) {
        f32x16 acc;
#pragma unroll
        for (int e = 0; e < 16; ++e) acc[e] = 0.f;
        if (tj <= ti) {
            const LAS unsigned char* kb = kl + (32 * tj + i) * 144 + hh * 16;
#pragma unroll
            for (int s = 0; s < 4; ++s) acc = MFMA32(*(const LAS bf16x8*)(kb + s * 32), qf[s], acc);
            if (tj == ti) {
#pragma unroll
                for (int e = 0; e < 16; ++e) if (crow(e, hh) > i) acc[e] = 0.f; }
        }
#pragma unroll
        for (int e = 0; e < 8; ++e) pk[tj][e] = cvtpk(acc[2 * e], acc[2 * e + 1]);
    }
    f32x16 y[2];
#pragma unroll
    for (int u = 0; u < 2; ++u) {
#pragma unroll
        for (int e = 0; e < 16; ++e) y[u][e] = 0.f;
        const float gam = __builtin_amdgcn_exp2f(lg2);
        const float* pr = ST + ((size_t)(b * 6 + h) * 64 + n) * 4096 + (size_t)(32 * u + i) * 64 + 8 * hh;
#pragma unroll
        for (int s = 0; s < 4; ++s) { const f32x4 p0 = *(const GAS f32x4*)(pr + 16 * s), p1 = *(const GAS f32x4*)(pr + 16 * s + 4);
            const bf16x8 af = mk8u(cvtpk(p0[0] * gam, p0[1] * gam), cvtpk(p0[2] * gam, p0[3] * gam), cvtpk(p1[0] * gam, p1[1] * gam), cvtpk(p1[2] * gam, p1[3] * gam));
            y[u] = MFMA32(af, qf[s], y[u]); }
#pragma unroll
        for (int tj = 0; tj < 4; ++tj) if (tj <= ti) {
#pragma unroll
            for (int s2 = 0; s2 < 2; ++s2) y[u] = MFMA32(tr_frag(vl, 32 * tj + 16 * s2, u, lane), mk8u(pk[tj][4 * s2], pk[tj][4 * s2 + 1], pk[tj][4 * s2 + 2], pk[tj][4 * s2 + 3]), y[u]); }
    }
    float s1 = 0.f;
#pragma unroll
    for (int u = 0; u < 2; ++u)
#pragma unroll
        for (int e = 0; e < 16; ++e) s1 += y[u][e];
    const float mu = half_sum(s1) * (1.f / 64.f);
    float s2 = 0.f;
#pragma unroll
    for (int u = 0; u < 2; ++u)
#pragma unroll
        for (int e = 0; e < 16; ++e) { y[u][e] -= mu; s2 += y[u][e] * y[u][e]; }
    const float rs = 1.f / sqrtf(half_sum(s2) * (1.f / 64.f) + EPS);
    { int lane2 = lane; asm volatile("" : "+v"(lane2)); const int i2 = lane2 & 31, hh2 = lane2 >> 5; const size_t row2 = row0 + 32 * ti + i2;
      const bf16* gp = Z + row2 * INWP + ZGC + h * 64 + 4 * hh2; bf16* op = MIX + row2 * D + MIX_C + h * 64 + 4 * hh2;
#pragma unroll
      for (int u = 0; u < 2; ++u)
#pragma unroll
          for (int c4 = 0; c4 < 4; ++c4) {
              const unsigned long long gw = *(const GAS unsigned long long*)(gp + 32 * u + 8 * c4); const unsigned glo = (unsigned)gw, ghi = (unsigned)(gw >> 32);
              const float g[4] = {bf_lo(glo), bf_hi(glo), bf_lo(ghi), bf_hi(ghi)}; float o[4];
#pragma unroll
              for (int q = 0; q < 4; ++q) o[q] = g[q] / (1.f + __expf(-g[q])) * y[u][4 * c4 + q] * rs;
              *(GAS unsigned long long*)(op + 32 * u + 8 * c4) = (unsigned long long)cvtpk(o[0], o[1]) | ((unsigned long long)cvtpk(o[2], o[3]) << 32); } }
    __syncthreads();
}

__device__ __forceinline__ void sgu_unit(const bf16* Z, bf16* MIX, const float* sw, const float* sb, const float* lng, const float* lnb, LAS unsigned char* lds, int unit, int tid) {
    const int lane = tid & 63, w = __builtin_amdgcn_readfirstlane(tid >> 6); const size_t row0 = (size_t)unit * 128;
    { const f32x4 lg = *(const GAS f32x4*)(lng + 4 * lane), lb = *(const GAS f32x4*)(lnb + 4 * lane);
      for (int j = w; j < 128; j += NWAVES) {
          const unsigned long long v8 = *((const GAS unsigned long long*)(Z + (row0 + j) * INWP + ZVB) + lane); const unsigned lo = (unsigned)v8, hi = (unsigned)(v8 >> 32);
          float v[4] = {gelu_tanh(bf_lo(lo)), gelu_tanh(bf_hi(lo)), gelu_tanh(bf_lo(hi)), gelu_tanh(bf_hi(hi))};
          const float mu = wave_sum((v[0] + v[1]) + (v[2] + v[3])) * (1.f / 256.f);
          float q = 0.f;
#pragma unroll
          for (int c = 0; c < 4; ++c) { v[c] -= mu; q += v[c] * v[c]; }
          const float rs = 1.f / sqrtf(wave_sum(q) * (1.f / 256.f) + EPS);
          const unsigned o0 = cvtpk(v[0] * rs * lg[0] + lb[0], v[1] * rs * lg[1] + lb[1]), o1 = cvtpk(v[2] * rs * lg[2] + lb[2], v[3] * rs * lg[3] + lb[3]);
          *(LAS unsigned long long*)(lds + j * 512 + (((lane >> 1) ^ ((j & 3) << 2)) << 4) + 8 * (lane & 1)) = (unsigned long long)o0 | ((unsigned long long)o1 << 32);
      } }
    __syncthreads();
    const int ti = w & 3, gh = w >> 2, i = lane & 31, hh = lane >> 5, g1 = (lane >> 4) & 1, q4 = (lane & 15) >> 2, p4 = lane & 3;
    const int il = 32 * ti + i;
    f32x16 acc[2][2];
#pragma unroll
    for (int gg = 0; gg < 2; ++gg)
#pragma unroll
        for (int ct = 0; ct < 2; ++ct)
#pragma unroll
            for (int e = 0; e < 16; ++e) acc[gg][ct][e] = 0.f;
    LAS unsigned char* vb = lds + (4 * hh + q4) * 512 + ((2 * g1 + (p4 >> 1)) << 4) + 8 * (p4 & 1);
#pragma unroll
    for (int tj = 0; tj < 4; ++tj) if (tj <= ti) {
#pragma unroll
        for (int s2 = 0; s2 < 2; ++s2) {
            const int j0 = 32 * tj + 16 * s2 + 4 * hh;
#pragma unroll
            for (int gg = 0; gg < 2; ++gg) { const int g = 2 * gh + gg;
                const float* wp = sw + ((size_t)g * 128 + il) * 128 + j0;
                f32x4 w0 = *(const GAS f32x4*)wp, w1 = *(const GAS f32x4*)(wp + 8);
                if (tj == ti) {
#pragma unroll
                    for (int q = 0; q < 4; ++q) { if (j0 + q > il) w0[q] = 0.f; if (j0 + 8 + q > il) w1[q] = 0.f; } }
                const bf16x8 bfrag = mk8u(cvtpk(w0[0], w0[1]), cvtpk(w0[2], w0[3]), cvtpk(w1[0], w1[1]), cvtpk(w1[2], w1[3]));
#pragma unroll
                for (int ct = 0; ct < 2; ++ct) {
                    LAS unsigned char* p = vb + (32 * tj + 16 * s2) * 512 + ((((2 * g + ct) ^ q4) << 2) << 4);
                    acc[gg][ct] = MFMA32(mk8(tr16(p), tr16(p + 8 * 512)), bfrag, acc[gg][ct]);
                }
            }
        }
    }
    { int lane2 = lane; asm volatile("" : "+v"(lane2)); const int i2 = lane2 & 31, hh2 = lane2 >> 5; const size_t row = row0 + 32 * ti + i2;
#pragma unroll
      for (int gg = 0; gg < 2; ++gg) { const int g = 2 * gh + gg; const float bias = sb[g * 128 + 32 * ti + i2];
          const bf16* up = Z + row * INWP + ZUB + g * 64 + 4 * hh2; bf16* op = MIX + row * D + MIX_B + g * 64 + 4 * hh2;
#pragma unroll
          for (int ct = 0; ct < 2; ++ct)
#pragma unroll
              for (int c4 = 0; c4 < 4; ++c4) {
                  const unsigned long long uw = *(const GAS unsigned long long*)(up + 32 * ct + 8 * c4); const unsigned ulo = (unsigned)uw, uhi = (unsigned)(uw >> 32);
                  const float o0 = gelu_tanh(bf_lo(ulo)) * (acc[gg][ct][4 * c4] + bias), o1 = gelu_tanh(bf_hi(ulo)) * (acc[gg][ct][4 * c4 + 1] + bias);
                  const float o2 = gelu_tanh(bf_lo(uhi)) * (acc[gg][ct][4 * c4 + 2] + bias), o3 = gelu_tanh(bf_hi(uhi)) * (acc[gg][ct][4 * c4 + 3] + bias);
                  *(GAS unsigned long long*)(op + 32 * ct + 8 * c4) = (unsigned long long)cvtpk(o0, o1) | ((unsigned long long)cvtpk(o2, o3) << 32); } } }
    __syncthreads();
}
struct Args { const float* in[15]; float* out; unsigned char* ws; float inv[32]; int ph_lo, ph_hi; };
typedef __attribute__((address_space(4))) const Args* KArgs;
#define WSP(T, off) ((T*)(ws + (off)))
__global__ void __launch_bounds__(NWAVES * 64, 2) mk_fwd(Args args_unused) {
    extern __shared__ __attribute__((aligned(16))) unsigned char lds_raw[];
    LAS unsigned char* lds = (LAS unsigned char*)lds_raw;
    { const int t0 = threadIdx.x; for (int u = t0; u < (LDS_BYTES - LDSCTL_OFF) / 4; u += NWAVES * 64) ((LAS unsigned*)(lds + LDSCTL_OFF))[u] = 0u; }
    __syncthreads();
    KArgs ap = (KArgs)__builtin_amdgcn_kernarg_segment_ptr();
#if ONE_LAUNCH
    XcdBarrier bar = xcd_barrier_post((unsigned*)(ap->ws + WS_CTL) + CW_BAR, (volatile LAS unsigned*)(lds + MISC_OFF) + 8);
#endif
    const int ph_lo = ap->ph_lo, ph_hi = ap->ph_hi;
    for (int ph = ph_lo; ph < ph_hi; ++ph) {
        asm volatile("" : "+s"(ap));
        unsigned char* ws = ap->ws;
        const int G = gridDim.x, bx = blockIdx.x; const int vcu = (G % 8 == 0) ? (bx % 8) * (G / 8) + bx / 8 : bx;
        const int NGW = G * NWAVES, NGT = G * NWAVES * 64;
#define PH_TID int tid = threadIdx.x; asm volatile("" : "+v"(tid)); const int lane = tid & 63, wave = __builtin_amdgcn_readfirstlane(tid >> 6); const int gw = vcu * NWAVES + wave, gt = vcu * NWAVES * 64 + tid; (void)lane; (void)gw; (void)gt;
        const int l = ph / NPH_LAYER, k = ph % NPH_LAYER;
        if (k == 0) { PH_TID
            LAS float* scr = (LAS float*)(lds + RING_OFF + wave * 16384);
            constexpr int I_IN = 16 * 100, I_SQ = 16 * 32, I_KV = 16 * 64, I_UP = 16 * 128, I_DN = 64 * 32;
            constexpr int NITEMS = I_IN + 3 * I_SQ + I_KV + I_UP + I_DN;
            for (int it = gw; it < NITEMS; it += NGW) {
                int r = it;
                if (r < I_IN) { tr_item(ap->in[4] + (size_t)l * D * INW, D, INW, WSP(bf16, WS_WIN), 1, scr, r, lane); continue; } r -= I_IN;
                if (r < I_SQ) { tr_item(ap->in[9] + (size_t)l * D * D, D, D, WSP(bf16, WS_WOUT), 0, scr, r, lane); continue; } r -= I_SQ;
                if (r < I_SQ) { tr_item(ap->in[10] + (size_t)l * D * D, D, D, WSP(bf16, WS_WQ), 0, scr, r, lane); continue; } r -= I_SQ;
                if (r < I_KV) { tr_item(ap->in[11] + (size_t)l * D * 2 * D, D, 2 * D, WSP(bf16, WS_WKV), 0, scr, r, lane); continue; } r -= I_KV;
                if (r < I_SQ) { tr_item(ap->in[12] + (size_t)l * D * D, D, D, WSP(bf16, WS_WO), 0, scr, r, lane); continue; } r -= I_SQ;
                if (r < I_UP) { tr_item(ap->in[13] + (size_t)l * D * FF, D, FF, WSP(bf16, WS_WUP), 0, scr, r, lane); continue; } r -= I_UP;
                tr_item(ap->in[14] + (size_t)l * FF * D, FF, D, WSP(bf16, WS_WDN), 0, scr, r, lane);
            }
            if (l == 0) {
                const float* x_in = ap->in[0]; const float* mem = ap->in[1]; const int* positions = (const int*)ap->in[2]; const float* norm_g = ap->in[3];
                bf16* Win_t = WSP(bf16, WS_WIN); bf16* XN = WSP(bf16, WS_XN); bf16* MEMN = WSP(bf16, WS_MEMN); float* COS = WSP(float, WS_COS); float* SIN = WSP(float, WS_SIN);
                for (int i = gt; i < (INWP - INW) * D / 8; i += NGT) ((GAS v4u*)(Win_t + (size_t)INW * D))[i] = (v4u){0u, 0u, 0u, 0u};
                for (int m = gw; m < M; m += NGW) rms_row_to_bf16(x_in + (size_t)m * D, norm_g, XN + (size_t)m * D, lane);
                for (int m = gw; m < DEPTH * 512; m += NGW) { const int ll = m >> 9, mr = m & 511;
                    rms_row_to_bf16(mem + (size_t)mr * D, norm_g + ((size_t)ll * 7 + 6) * D, MEMN + (size_t)m * D, lane); }
                for (int i = gt; i < M * 32; i += NGT) { const int j = i & 31, row = i >> 5;
                    const float ang = (float)positions[row] * ap->inv[j];
                    const double rev = (double)ang * 0.15915494309189535; const float fr = (float)(rev - rint(rev));
                    COS[i] = __builtin_amdgcn_cosf(fr); SIN[i] = __builtin_amdgcn_sinf(fr); }
            }
        } else if (k == 1 || k == 5 || k == 7 || k == 9 || k == 11 || k == 12) {
            PH_TID
            const int ngemm = (k == 7) ? 2 : 1;
            for (int gi = 0; gi < ngemm; ++gi) {
                const bf16* gA; const bf16* gB; bf16* gO; int gM, gN, gldc, gact = 0;
                if (k == 1)       { gA = WSP(bf16, WS_XN); gB = WSP(bf16, WS_WIN); gM = M; gN = INWP; gO = WSP(bf16, WS_Z); gldc = INWP; }
                else if (k == 5)  { gA = WSP(bf16, WS_MIX); gB = WSP(bf16, WS_WOUT); gM = M; gN = D; gO = WSP(bf16, WS_Y); gldc = D; }
                else if (k == 7)  { if (gi == 0) { gA = WSP(bf16, WS_XN); gB = WSP(bf16, WS_WQ); gM = M; gN = D; gO = WSP(bf16, WS_Q); gldc = D; }
                                    else { gA = WSP(bf16, WS_MEMN) + (size_t)l * 512 * D; gB = WSP(bf16, WS_WKV); gM = 512; gN = 2 * D; gO = WSP(bf16, WS_MKV); gldc = 2 * D; } }
                else if (k == 9)  { gA = WSP(bf16, WS_MIX); gB = WSP(bf16, WS_WO); gM = M; gN = D; gO = WSP(bf16, WS_Y); gldc = D; }
                else if (k == 11) { gA = WSP(bf16, WS_XN); gB = WSP(bf16, WS_WUP); gM = M; gN = FF; gO = WSP(bf16, WS_H); gldc = FF; gact = 2; }
                else              { gA = WSP(bf16, WS_H); gB = WSP(bf16, WS_WDN); gM = M; gN = D; gO = WSP(bf16, WS_MIX); gldc = D; }
                pg8::StaticOrder S; S.init(gM, gN, G, bx);
                const pg8::EpiBf16 E{gO, gldc, gact};
                if (k == 12) pg8::gemm_phase<pg8::EpiBf16, pg8::StaticOrder, true, true>(lds + RING_OFF, pg8::Gemm{gA, gB, gM, gN, FF}, S, E, tid);
                else         pg8::gemm_phase<pg8::EpiBf16, pg8::StaticOrder, true, true>(lds + RING_OFF, pg8::Gemm{gA, gB, gM, gN, D}, S, E, tid);
                __syncthreads();
            }
        } else if (k == 2) { PH_TID
            constexpr int T_DIL = DIL_UNITS, T_SGU = M / 128, T_RET = 2 * 64 * 6 / 2;
            for (int t = bx; t < T_DIL + T_SGU + T_RET; t += G) {
                if (t < T_DIL) dil_unit(WSP(bf16, WS_Z), WSP(bf16, WS_OBR01), WSP(bf16, WS_OBR2), WSP(float, WS_LSE), lds, t, tid);
                else if (t < T_DIL + T_SGU) sgu_unit(WSP(bf16, WS_Z), WSP(bf16, WS_MIX), ap->in[5] + (size_t)l * 4 * 128 * 128, ap->in[6] + (size_t)l * 4 * 128, ap->in[7] + (size_t)l * 256, ap->in[8] + (size_t)l * 256, lds, t - T_DIL, tid);
                else ret1_pair(WSP(bf16, WS_Z), WSP(float, WS_COS), WSP(float, WS_SIN), WSP(float, WS_KV), lds, t - T_DIL - T_SGU, tid);
            }
        } else if (k == 3) { PH_TID
            float* KV = WSP(float, WS_KV);
            for (int i = gt; i < 12 * 4096; i += NGT) { const int bh = i >> 12, el = i & 4095, h = bh % 6;
                const float cd = __expf(128.f * log1pf(-exp2f(-5.f - (float)h)));
                float* p = KV + (size_t)bh * 64 * 4096 + el; float st = 0.f;
                for (int n = 0; n < 64; ++n) { const float t = p[(size_t)n * 4096]; p[(size_t)n * 4096] = st; st = cd * st + t; } }
            dil_combine(WSP(bf16, WS_OBR01), WSP(bf16, WS_OBR2), WSP(float, WS_LSE), WSP(bf16, WS_MIX), gt, NGT);
        } else if (k == 4) { PH_TID
            for (int t = bx; t < 2 * 64 * 6 / 2; t += G) ret2_pair(WSP(bf16, WS_Z), WSP(float, WS_COS), WSP(float, WS_SIN), WSP(float, WS_KV), WSP(bf16, WS_MIX), lds, t, tid);
        } else if (k == 6 || k == 10 || k == 13) { PH_TID
            const float* norm_g = ap->in[3]; const float* ng = norm_g + (size_t)l * 7 * D; float* out = ap->out;
            const float* xin = (l == 0 && k == 6) ? ap->in[0] : out;
            const bf16* y = (k == 13) ? WSP(bf16, WS_MIX) : WSP(bf16, WS_Y);
            const float* gpost = ng + (size_t)(k == 6 ? 1 : (k == 10 ? 3 : 5)) * D;
            const float* gpre = (k == 6) ? ng + 2 * D : (k == 10 ? ng + 4 * D : (l + 1 < DEPTH ? norm_g + (size_t)(l + 1) * 7 * D : nullptr));
            bf16* XN = WSP(bf16, WS_XN);
            for (int m = gw; m < M; m += NGW) res_row(xin + (size_t)m * D, y + (size_t)m * D, gpost, gpre, out + (size_t)m * D, XN + (size_t)m * D, lane);
        } else if (k == 8) { PH_TID
            for (int t = bx; t < 256; t += G) xattn_unit(WSP(bf16, WS_Q), WSP(bf16, WS_MKV), WSP(bf16, WS_MIX), lds, t, tid);
        }
#if ONE_LAUNCH
        if (ph + 1 < ph_hi) xcd_barrier(bar);
#endif
    }
}

extern "C" void kernel_launch(void* const* d_in, const int* in_sizes, int n_in, void* d_out, int out_size, void* d_ws, size_t ws_size, hipStream_t stream) {
    static int grid = 0;
    if (grid == 0) {
        if (n_in != 15 || out_size != M * D || ws_size < WS_END) { fprintf(stderr, "kernel_launch: unexpected shapes (n_in %d out %d ws %zu)\n", n_in, out_size, ws_size); grid = -1; return; }
        int dev = 0, cus = 0, per_cu = 0;
        if (hipGetDevice(&dev) != hipSuccess || hipDeviceGetAttribute(&cus, hipDeviceAttributeMultiprocessorCount, dev) != hipSuccess) { grid = -1; return; }
        if (hipFuncSetAttribute((const void*)mk_fwd, hipFuncAttributeMaxDynamicSharedMemorySize, LDS_BYTES) != hipSuccess) { fprintf(stderr, "kernel_launch: hipFuncSetAttribute failed\n"); grid = -1; return; }
        if (hipOccupancyMaxActiveBlocksPerMultiprocessor(&per_cu, (const void*)mk_fwd, NWAVES * 64, LDS_BYTES) != hipSuccess || per_cu < 1) { fprintf(stderr, "kernel_launch: occupancy query says %d blocks per CU\n", per_cu); }
        (void)hipGetLastError();
        grid = cus;
    }
    if (grid < 0) return;
    (void)hipMemsetAsync((char*)d_ws + WS_CTL, 0, CTL_ZERO_BYTES, stream);
    Args a{};
    for (int i = 0; i < 15; ++i) a.in[i] = (const float*)d_in[i];
    a.out = (float*)d_out; a.ws = (unsigned char*)d_ws;
    for (int j = 0; j < 32; ++j) a.inv[j] = (float)(1.0 / pow(10000.0, (double)((float)j / 31.0f)));
#if ONE_LAUNCH
    a.ph_lo = 0; a.ph_hi = NPH;
    hipLaunchKernelGGL(mk_fwd, dim3(grid), dim3(NWAVES * 64), LDS_BYTES, stream, a);
#else
    for (int p = 0; p < NPH; ++p) { a.ph_lo = p; a.ph_hi = p + 1; hipLaunchKernelGGL(mk_fwd, dim3(grid), dim3(NWAVES * 64), LDS_BYTES, stream, a); }
#endif
}
```
